# Optimizing an MI355X kernel written in HIP

```python
import math
import jax, jax.numpy as jnp
from jax import lax
import numpy as np


D_MODEL = 1024
BATCH = 1
SEQ = 16384
DEPTH = 4

CHUNK = 64
N_MIXERS = 3
N_S5_LAYERS = (DEPTH + 2) // 3
N_GLA_LAYERS = (DEPTH + 1) // 3
N_DIFF_LAYERS = DEPTH // 3
NORM_EPS = 1e-6
S5_GROUP = 16
S5_GROUPS = D_MODEL // S5_GROUP
S5_STATE = 64
DT_MIN = 1e-3
DT_MAX = 1e-1
GLA_HEADS = 4
GLA_DK = D_MODEL // 2
GLA_DV = D_MODEL
GLA_DKH = GLA_DK // GLA_HEADS
GLA_DVH = GLA_DV // GLA_HEADS
GLA_GATE_RANK = 16
GLA_TEMP = 16.0
GLA_IN = 2 * GLA_DK + 2 * GLA_DV + GLA_GATE_RANK
DIFF_HD = 64
DIFF_HEADS = D_MODEL // (2 * DIFF_HD)
ROT_DIMS = DIFF_HD // 4
ROPE_THETA = 500000.0
Q_BLOCK = 128
NEG_INF = -1e30
FFN_HIDDEN = -(-8 * D_MODEL // (3 * 256)) * 256

kernel_name = 'hybrid_s5_gla_diffattn_trunk'


def rmsnorm(x, g):
    xf = x.astype(jnp.float32)
    y = xf * lax.rsqrt(jnp.mean(xf * xf, axis=-1, keepdims=True) + NORM_EPS)
    return (y * g.astype(jnp.float32)).astype(x.dtype)


def swiglu_ffn(h, w_gate_up, w_down):
    g, u = jnp.split(h @ w_gate_up, 2, axis=-1)
    return (jax.nn.silu(g) * u) @ w_down


def _cdiag_combine(e1, e2):
    a1r, a1i, b1r, b1i = e1
    a2r, a2i, b2r, b2i = e2
    ar = a2r * a1r - a2i * a1i
    ai = a2r * a1i + a2i * a1r
    br = a2r * b1r - a2i * b1i + b2r
    bi = a2r * b1i + a2i * b1r + b2i
    return (ar, ai, br, bi)


def s5_mixer(h, lam_re, lam_im, log_dt, b_re, b_im, c_re, c_im, d_skip, w_glu):
    bsz, seq, _ = h.shape
    n_chunks = seq // CHUNK
    f32 = jnp.float32
    lr = lam_re.astype(f32)
    li = lam_im.astype(f32)
    dt = jnp.exp(log_dt.astype(f32))[:, None]
    ab_mag = jnp.exp(lr * dt)
    ab_ang = li * dt
    ab_re = ab_mag * jnp.cos(ab_ang)
    ab_im = ab_mag * jnp.sin(ab_ang)
    den = lr * lr + li * li
    f_re = ((ab_re - 1.0) * lr + ab_im * li) / den
    f_im = (ab_im * lr - (ab_re - 1.0) * li) / den
    br = b_re.astype(f32)
    bi = b_im.astype(f32)
    bb_re = f_re[..., None] * br - f_im[..., None] * bi
    bb_im = f_re[..., None] * bi + f_im[..., None] * br
    j = jnp.arange(1, CHUNK + 1, dtype=f32)[:, None, None]
    p_mag = jnp.exp(lr * dt * j)
    p_ang = li * dt * j
    p_re = p_mag * jnp.cos(p_ang)
    p_im = p_mag * jnp.sin(p_ang)
    cr = c_re.astype(f32)
    ci = c_im.astype(f32)
    u = h.astype(f32).reshape(bsz, n_chunks, CHUNK, S5_GROUPS, S5_GROUP)
    u = jnp.moveaxis(u, 1, 0)

    def chunk_step(carry, u_c):
        s_re0, s_im0 = carry
        bu_re = jnp.einsum('bcgh,gph->bcgp', u_c, bb_re)
        bu_im = jnp.einsum('bcgh,gph->bcgp', u_c, bb_im)
        a_re = jnp.broadcast_to(ab_re, bu_re.shape)
        a_im = jnp.broadcast_to(ab_im, bu_re.shape)
        _, _, s_re, s_im = lax.associative_scan(_cdiag_combine, (a_re, a_im, bu_re, bu_im), axis=1)
        s_re = s_re + p_re * s_re0[:, None] - p_im * s_im0[:, None]
        s_im = s_im + p_re * s_im0[:, None] + p_im * s_re0[:, None]
        y = jnp.einsum('bcgp,ghp->bcgh', s_re, cr) - jnp.einsum('bcgp,ghp->bcgh', s_im, ci)
        return (s_re[:, -1], s_im[:, -1]), y

    zeros = jnp.zeros((bsz, S5_GROUPS, S5_STATE), f32)
    _, y = lax.scan(chunk_step, (zeros, zeros), u)
    y = jnp.moveaxis(y, 0, 1).reshape(bsz, seq, D_MODEL)
    y = y + d_skip.astype(f32) * h.astype(f32)
    z = jax.nn.gelu(y).astype(h.dtype)
    a, b = jnp.split(z @ w_glu, 2, axis=-1)
    return a * jax.nn.sigmoid(b)


def gla_mixer(h, w_in, w_a2, b_a, norm_g, w_o):
    bsz, seq, _ = h.shape
    nc = seq // CHUNK
    f32 = jnp.float32
    proj = h @ w_in
    q, k, v, g, a_lo = jnp.split(proj, [GLA_DK, 2 * GLA_DK, 2 * GLA_DK + GLA_DV, 2 * GLA_DK + 2 * GLA_DV], axis=-1)
    log_a = jax.nn.log_sigmoid((a_lo @ w_a2 + b_a).astype(f32)) / GLA_TEMP
    shp_k = (bsz, nc, CHUNK, GLA_HEADS, GLA_DKH)
    q = q.astype(f32).reshape(shp_k) * GLA_DKH ** -0.5
    k = k.astype(f32).reshape(shp_k)
    v = v.astype(f32).reshape(bsz, nc, CHUNK, GLA_HEADS, GLA_DVH)
    cum = jnp.cumsum(log_a.reshape(shp_k), axis=2)
    tot = cum[:, :, -1]
    k_dec = k * jnp.exp(tot[:, :, None] - cum)
    upd = jnp.einsum('bnchk,bnchv->bnhkv', k_dec, v)
    decay = jnp.exp(tot)

    def chunk_step(state, xs):
        dec_c, upd_c = xs
        state = dec_c[..., None] * state + upd_c
        return state, state

    init = jnp.zeros((bsz, GLA_HEADS, GLA_DKH, GLA_DVH), f32)
    _, states = lax.scan(chunk_step, init, (jnp.moveaxis(decay, 1, 0), jnp.moveaxis(upd, 1, 0)))
    states = jnp.moveaxis(states, 0, 1)
    o = jnp.einsum('bnchk,bnhkv->bnchv', q, states).reshape(bsz, seq, GLA_HEADS, GLA_DVH)
    o = o * lax.rsqrt(jnp.mean(o * o, axis=-1, keepdims=True) + NORM_EPS) * norm_g.astype(f32).reshape(GLA_HEADS, GLA_DVH)
    o = o.reshape(bsz, seq, GLA_DV) * jax.nn.silu(g.astype(f32))
    return o.astype(h.dtype) @ w_o


def partial_rope(x, positions):
    f32 = jnp.float32
    half = ROT_DIMS // 2
    inv_freq = ROPE_THETA ** (-jnp.arange(half, dtype=f32) / half)
    ang = positions.astype(f32)[..., None] * inv_freq
    cos = jnp.cos(ang)[:, :, None]
    sin = jnp.sin(ang)[:, :, None]
    xf = x.astype(f32)
    x1 = xf[..., :half]
    x2 = xf[..., half:ROT_DIMS]
    return jnp.concatenate([x1 * cos - x2 * sin, x2 * cos + x1 * sin, xf[..., ROT_DIMS:]], axis=-1)


def diff_attn_mixer(h, positions, w_qkv, lam_q1, lam_k1, lam_q2, lam_k2, subln_g, w_o, lambda_init):
    bsz, seq, _ = h.shape
    f32 = jnp.float32
    q, k, v = jnp.split(h @ w_qkv, 3, axis=-1)
    q = partial_rope(q.reshape(bsz, seq, 2 * DIFF_HEADS, DIFF_HD), positions) * DIFF_HD ** -0.5
    k = partial_rope(k.reshape(bsz, seq, 2 * DIFF_HEADS, DIFF_HD), positions)
    v = v.astype(f32).reshape(bsz, seq, DIFF_HEADS, 2 * DIFF_HD)
    lam = (jnp.exp(jnp.sum(lam_q1.astype(f32) * lam_k1.astype(f32)))
           - jnp.exp(jnp.sum(lam_q2.astype(f32) * lam_k2.astype(f32))) + lambda_init)
    chunk_id = positions // CHUNK
    nqb = seq // Q_BLOCK
    q_blk = jnp.moveaxis(q.reshape(bsz, nqb, Q_BLOCK, 2 * DIFF_HEADS, DIFF_HD), 1, 0)
    cid_blk = jnp.moveaxis(chunk_id.reshape(bsz, nqb, Q_BLOCK), 1, 0)

    def attend_block(args):
        qb, qcid = args
        s = jnp.einsum('bqhd,bkhd->bhqk', qb, k)
        mask = chunk_id[:, None, None, :] <= qcid[:, None, :, None]
        p = jax.nn.softmax(jnp.where(mask, s, NEG_INF), axis=-1)
        p = p.reshape(bsz, DIFF_HEADS, 2, Q_BLOCK, seq)
        a = p[:, :, 0] - lam * p[:, :, 1]
        return jnp.einsum('bhqk,bkhd->bqhd', a, v)

    o = lax.map(attend_block, (q_blk, cid_blk))
    o = jnp.moveaxis(o, 0, 1).reshape(bsz, seq, DIFF_HEADS, 2 * DIFF_HD)
    o = o * lax.rsqrt(jnp.mean(o * o, axis=-1, keepdims=True) + 1e-5) * subln_g.astype(f32)
    o = o * (1.0 - lambda_init)
    return o.reshape(bsz, seq, D_MODEL).astype(h.dtype) @ w_o


def setup_inputs(seed: int = 0) -> dict:
    key = jax.random.key(seed)
    ks = iter(jax.random.split(key, 32))
    nrm = lambda shape, scale: scale * jax.random.normal(next(ks), shape, jnp.float32)
    x = jax.random.normal(next(ks), (BATCH, SEQ, D_MODEL), jnp.float32)
    positions = jnp.broadcast_to(jnp.arange(SEQ, dtype=jnp.int32), (BATCH, SEQ))
    norm_mix = 1.0 + nrm((DEPTH, D_MODEL), 0.02)
    norm_ffn = 1.0 + nrm((DEPTH, D_MODEL), 0.02)
    norm_final = 1.0 + nrm((D_MODEL,), 0.02)
    s5_lam_re = -0.5 * jnp.exp(nrm((N_S5_LAYERS, S5_GROUPS, S5_STATE), 0.05))
    s5_lam_im = jnp.pi * jnp.arange(S5_STATE, dtype=jnp.float32) + nrm((N_S5_LAYERS, S5_GROUPS, S5_STATE), 0.01)
    s5_log_dt = jax.random.uniform(next(ks), (N_S5_LAYERS, S5_GROUPS), jnp.float32, math.log(DT_MIN), math.log(DT_MAX))
    s5_b_re = nrm((N_S5_LAYERS, S5_GROUPS, S5_STATE, S5_GROUP), (2 * S5_GROUP) ** -0.5)
    s5_b_im = nrm((N_S5_LAYERS, S5_GROUPS, S5_STATE, S5_GROUP), (2 * S5_GROUP) ** -0.5)
    s5_c_re = nrm((N_S5_LAYERS, S5_GROUPS, S5_GROUP, S5_STATE), S5_STATE ** -0.5)
    s5_c_im = nrm((N_S5_LAYERS, S5_GROUPS, S5_GROUP, S5_STATE), S5_STATE ** -0.5)
    s5_d = nrm((N_S5_LAYERS, D_MODEL), 1.0)
    s5_w_glu = nrm((N_S5_LAYERS, D_MODEL, 2 * D_MODEL), D_MODEL ** -0.5)
    gla_w_in = nrm((N_GLA_LAYERS, D_MODEL, GLA_IN), D_MODEL ** -0.5)
    gla_w_a2 = nrm((N_GLA_LAYERS, GLA_GATE_RANK, GLA_DK), GLA_GATE_RANK ** -0.5)
    gla_b_a = nrm((N_GLA_LAYERS, GLA_DK), 0.1)
    gla_norm = 1.0 + nrm((N_GLA_LAYERS, GLA_DV), 0.02)
    gla_w_o = nrm((N_GLA_LAYERS, GLA_DV, D_MODEL), GLA_DV ** -0.5)
    diff_w_qkv = nrm((N_DIFF_LAYERS, D_MODEL, 3 * D_MODEL), D_MODEL ** -0.5)
    diff_lam_q1 = nrm((N_DIFF_LAYERS, DIFF_HD), 0.1)
    diff_lam_k1 = nrm((N_DIFF_LAYERS, DIFF_HD), 0.1)
    diff_lam_q2 = nrm((N_DIFF_LAYERS, DIFF_HD), 0.1)
    diff_lam_k2 = nrm((N_DIFF_LAYERS, DIFF_HD), 0.1)
    diff_subln = 1.0 + nrm((N_DIFF_LAYERS, 2 * DIFF_HD), 0.02)
    diff_w_o = nrm((N_DIFF_LAYERS, D_MODEL, D_MODEL), D_MODEL ** -0.5)
    ffn_w_gate_up = nrm((DEPTH, D_MODEL, 2 * FFN_HIDDEN), D_MODEL ** -0.5)
    ffn_w_down = nrm((DEPTH, FFN_HIDDEN, D_MODEL), FFN_HIDDEN ** -0.5)
    return {'x': x, 'positions': positions, 'norm_mix': norm_mix, 'norm_ffn': norm_ffn, 'norm_final': norm_final,
            's5_lam_re': s5_lam_re, 's5_lam_im': s5_lam_im, 's5_log_dt': s5_log_dt, 's5_b_re': s5_b_re, 's5_b_im': s5_b_im,
            's5_c_re': s5_c_re, 's5_c_im': s5_c_im, 's5_d': s5_d, 's5_w_glu': s5_w_glu,
            'gla_w_in': gla_w_in, 'gla_w_a2': gla_w_a2, 'gla_b_a': gla_b_a, 'gla_norm': gla_norm, 'gla_w_o': gla_w_o,
            'diff_w_qkv': diff_w_qkv, 'diff_lam_q1': diff_lam_q1, 'diff_lam_k1': diff_lam_k1, 'diff_lam_q2': diff_lam_q2,
            'diff_lam_k2': diff_lam_k2, 'diff_subln': diff_subln, 'diff_w_o': diff_w_o,
            'ffn_w_gate_up': ffn_w_gate_up, 'ffn_w_down': ffn_w_down}


def reference(x, positions, norm_mix, norm_ffn, norm_final,
              s5_lam_re, s5_lam_im, s5_log_dt, s5_b_re, s5_b_im, s5_c_re, s5_c_im, s5_d, s5_w_glu,
              gla_w_in, gla_w_a2, gla_b_a, gla_norm, gla_w_o,
              diff_w_qkv, diff_lam_q1, diff_lam_k1, diff_lam_q2, diff_lam_k2, diff_subln, diff_w_o,
              ffn_w_gate_up, ffn_w_down):
    for layer in range(DEPTH):
        kind = layer % N_MIXERS
        idx = layer // N_MIXERS
        h = rmsnorm(x, norm_mix[layer])
        if kind == 0:
            mix = s5_mixer(h, s5_lam_re[idx], s5_lam_im[idx], s5_log_dt[idx], s5_b_re[idx], s5_b_im[idx],
                           s5_c_re[idx], s5_c_im[idx], s5_d[idx], s5_w_glu[idx])
        elif kind == 1:
            mix = gla_mixer(h, gla_w_in[idx], gla_w_a2[idx], gla_b_a[idx], gla_norm[idx], gla_w_o[idx])
        else:
            lambda_init = 0.8 - 0.6 * math.exp(-0.3 * layer)
            mix = diff_attn_mixer(h, positions, diff_w_qkv[idx], diff_lam_q1[idx], diff_lam_k1[idx],
                                  diff_lam_q2[idx], diff_lam_k2[idx], diff_subln[idx], diff_w_o[idx], lambda_init)
        x = x + mix.astype(x.dtype)
        h = rmsnorm(x, norm_ffn[layer])
        x = x + swiglu_ffn(h, ffn_w_gate_up[layer], ffn_w_down[layer]).astype(x.dtype)
    return rmsnorm(x, norm_final)
```

```cpp
#include <hip/hip_runtime.h>
#include <hip/hip_cooperative_groups.h>
#include <hip/hip_bf16.h>
#include <cstdio>
#include <cstdint>
#include <cstddef>
#include <cmath>
namespace cg = cooperative_groups;
namespace pg8 {
#define PG8_LAS __attribute__((address_space(3)))
typedef unsigned short bf16_t;
typedef short bf16x8 __attribute__((ext_vector_type(8)));
typedef float f32x4 __attribute__((ext_vector_type(4)));
typedef unsigned u32x4 __attribute__((ext_vector_type(4)));
constexpr int BM = 256, BK = 64, HALF = 128, HTB = HALF * BK * 2  , STAGE_BYTES = 8 * HTB, NXCD = 8, WGM = 8;

__host__ __device__ __forceinline__ int lds_byte(int r, int c) { const int st = (r >> 4) * 2 + (c >> 5), rr = r & 15, cc = c & 31, ob = rr * 64 + cc * 2; return st * 1024 + (ob ^ (((ob >> 9) & 1) << 5)); }
__host__ __device__ __forceinline__ void stage_rc(int b, int& R, int& C) { const int st = b / 1024, sb = b % 1024, swz = sb ^ (((sb >> 9) & 1) << 5); R = (st >> 1) * 16 + swz / 64; C = (st & 1) * 32 + (swz % 64) / 2; }
__host__ __device__ __forceinline__ int perm32(int rho) { const int n = rho >> 4, i = rho & 15; return 8 * (i >> 2) + 4 * n + (i & 3); }

struct Unit { int pm, pn; };
struct Gemm { const bf16_t* A; const bf16_t* Bt; int M, N, K; };

struct StaticOrder {
    int nM, nN, nwg, G, c;
    __host__ __device__ void init(int M, int N, int G_, int c_) { nM = M / BM; nN = N / BM; nwg = nM * nN; G = G_; c = c_; }
    __host__ __device__ bool next(int i, Unit& u) const {
        const long L = (long)i * G + c; if (L >= nwg) return false;
        int wgid = (int)L; { const int q = nwg / NXCD, r = nwg % NXCD, xcd = wgid % NXCD, off = wgid / NXCD; wgid = (xcd < r ? xcd * (q + 1) : r * (q + 1) + (xcd - r) * q) + off; }
        const int nig = WGM * nN, gid = wgid / nig, fm = gid * WGM, gsz = (nM - fm) < WGM ? (nM - fm) : WGM;
        u.pm = fm + ((wgid % nig) % gsz); u.pn = (wgid % nig) / gsz; return true;
    }
    __device__ __forceinline__ void a_ready(const Unit&) const {}
    __device__ __forceinline__ void done(const Unit&) const {}
};
__device__ __forceinline__ unsigned cvt_pk_bf16(float lo, float hi) { unsigned r; asm volatile("v_cvt_pk_bf16_f32 %0, %1, %2" : "=v"(r) : "v"(lo), "v"(hi)); return r; }
typedef float f32x2 __attribute__((ext_vector_type(2)));
template <class Epi, class Sched, bool ALIGN_EPI = false, bool SP2 = false>
__device__ __forceinline__ void gemm_phase(PG8_LAS unsigned char* lds, const Gemm g, const Sched& S, const Epi& E) {
    int tid_ = threadIdx.x; asm volatile("" : "+v"(tid_));
    const int tid = tid_, wid = __builtin_amdgcn_readfirstlane(tid >> 6), lane = tid & 63, wr = wid >> 2, wc = wid & 3, fr = lane & 15, fq = lane >> 4;
    const int K = g.K, nt = K / BK;
    unsigned voffA[2], voffB[2];
#pragma unroll
    for (int i = 0; i < 2; ++i) { int R, C; stage_rc(tid * 16 + i * 8192, R, C); const int Rb = Epi::PERM ? ((R & ~31) + perm32(R & 31)) : R;
        voffA[i] = (unsigned)(R * K + C) * 2u; voffB[i] = (unsigned)(Rb * K + C) * 2u; }
    const size_t kstep = (size_t)(BK * 2);
    const size_t hstep = (size_t)HALF * K * 2;
    const size_t tstep = 2 * hstep;
    const unsigned ldsw = (unsigned)wid * 1024u;
    const int aoff = lds_byte(wr * 64 + fr, fq * 8), boff = lds_byte(wc * 32 + fr, fq * 8);
#define PG8_SA(b, h) (((b) * 2 + (h)) * HTB)
#define PG8_SB(b, h) ((4 + (b) * 2 + (h)) * HTB)
#define PG8_STAGE(bufoff, gbase, voff) do { _Pragma("unroll") for (int _i = 0; _i < 2; ++_i) \
        __builtin_amdgcn_global_load_lds((const unsigned*)((const char*)(gbase) + (voff)[_i]), (PG8_LAS unsigned*)(lds + (bufoff) + ldsw + _i * 8192), 16, 0, 0); } while (0)
#define PG8_LDA(dst, b, h) do { _Pragma("unroll") for (int m = 0; m < 4; ++m) _Pragma("unroll") for (int k = 0; k < 2; ++k) dst[m][k] = *(const PG8_LAS bf16x8*)(lds + PG8_SA(b, h) + aoff + m * 2048 + k * 1024); } while (0)
#define PG8_LDB(dst, b, h) do { _Pragma("unroll") for (int n = 0; n < 2; ++n) _Pragma("unroll") for (int k = 0; k < 2; ++k) dst[n][k] = *(const PG8_LAS bf16x8*)(lds + PG8_SB(b, h) + boff + n * 2048 + k * 1024); } while (0)
#define PG8_MMA(ai, bj, At, Bt) do { __builtin_amdgcn_s_setprio(1); _Pragma("unroll") for (int m = 0; m < 4; ++m) _Pragma("unroll") for (int n = 0; n < 2; ++n) _Pragma("unroll") for (int k = 0; k < 2; ++k) \
        acc[ai][bj][m][n] = __builtin_amdgcn_mfma_f32_16x16x32_bf16(Bt[n][k], At[m][k], acc[ai][bj][m][n], 0, 0, 0); __builtin_amdgcn_s_setprio(0); } while (0)
#define PG8_WAIT_V(n) asm volatile("s_waitcnt vmcnt(" #n ")" ::: "memory")
#define PG8_WAIT_L(n) asm volatile("s_waitcnt lgkmcnt(" #n ")" ::: "memory")
#define PG8_BAR __builtin_amdgcn_s_barrier()
#define PG8_SCHED __builtin_amdgcn_sched_barrier(0)
    Unit cur, nxt; int ui = 0;
    if (!S.next(0, cur)) return;
    f32x4 acc[2][2][4][2];
#pragma unroll
    for (int a = 0; a < 2; ++a)
#pragma unroll
        for (int b = 0; b < 2; ++b)
#pragma unroll
            for (int m = 0; m < 4; ++m)
#pragma unroll
                for (int n = 0; n < 2; ++n) acc[a][b][m][n] = (f32x4){0.f, 0.f, 0.f, 0.f};
    bf16x8 At[4][2], B0[2][2], B1[2][2];
    const char* cA = (const char*)g.A + (size_t)cur.pm * tstep; const char* cB = (const char*)g.Bt + (size_t)cur.pn * tstep;
    S.a_ready(cur);
    if constexpr (SP2) {
        PG8_STAGE(PG8_SB(0, 0), cB, voffB); PG8_STAGE(PG8_SB(0, 1), cB + hstep, voffB); PG8_STAGE(PG8_SA(0, 0), cA, voffA); PG8_STAGE(PG8_SA(0, 1), cA + hstep, voffA);
        if (wr == 1) PG8_BAR;
        PG8_WAIT_V(2); PG8_BAR;
        PG8_STAGE(PG8_SB(1, 0), cB + kstep, voffB); PG8_STAGE(PG8_SA(1, 0), cA + kstep, voffA); PG8_STAGE(PG8_SB(1, 1), cB + hstep + kstep, voffB);
        PG8_WAIT_V(6); PG8_BAR;
    } else {
        PG8_STAGE(PG8_SB(0, 0), cB, voffB); PG8_STAGE(PG8_SA(0, 0), cA, voffA); PG8_STAGE(PG8_SB(0, 1), cB + hstep, voffB); PG8_STAGE(PG8_SA(0, 1), cA + hstep, voffA);
        if (wr == 1) PG8_BAR;
        PG8_WAIT_V(4); PG8_BAR;
        PG8_STAGE(PG8_SB(1, 0), cB + kstep, voffB); PG8_STAGE(PG8_SA(1, 0), cA + kstep, voffA); PG8_STAGE(PG8_SB(1, 1), cB + hstep + kstep, voffB);
        PG8_WAIT_V(6); PG8_BAR;
    }
    for (;;) {
        const bool has_next = S.next(ui + 1, nxt);
        const char* nA = has_next ? (const char*)g.A + (size_t)nxt.pm * tstep : cA; const char* nB = has_next ? (const char*)g.Bt + (size_t)nxt.pn * tstep : cB;
        for (int t = 0; t < nt; t += 2) {
            const bool last = (t == nt - 2);
            const char* a1 = cA + (size_t)(t + 1) * kstep;
            const char* a2 = last ? nA : cA + (size_t)(t + 2) * kstep; const char* b2 = last ? nB : cB + (size_t)(t + 2) * kstep;
            const char* a3 = a2 + kstep; const char* b3 = b2 + kstep;
            if (last && has_next) S.a_ready(nxt);
            if constexpr (SP2) {
            PG8_LDB(B0, 0, 0); PG8_LDB(B1, 0, 1); PG8_SCHED; PG8_LDA(At, 0, 0); PG8_STAGE(PG8_SA(1, 1), a1 + hstep, voffA);
            PG8_WAIT_V(8); PG8_WAIT_L(0); PG8_BAR; PG8_MMA(0, 0, At, B0); PG8_MMA(0, 1, At, B1); PG8_BAR; PG8_SCHED;
            PG8_LDA(At, 0, 1); PG8_STAGE(PG8_SB(0, 0), b2, voffB); PG8_STAGE(PG8_SB(0, 1), b2 + hstep, voffB); PG8_STAGE(PG8_SA(0, 0), a2, voffA);
            PG8_WAIT_V(8); PG8_WAIT_L(0); PG8_BAR; PG8_MMA(1, 0, At, B0); PG8_MMA(1, 1, At, B1); PG8_BAR; PG8_SCHED;
            PG8_LDB(B0, 1, 0); PG8_LDB(B1, 1, 1); PG8_SCHED; PG8_LDA(At, 1, 0); PG8_STAGE(PG8_SA(0, 1), a2 + hstep, voffA);
            PG8_WAIT_V(8); PG8_WAIT_L(0); PG8_BAR; PG8_MMA(0, 0, At, B0); PG8_MMA(0, 1, At, B1); PG8_BAR; PG8_SCHED;
            PG8_LDA(At, 1, 1); PG8_STAGE(PG8_SB(1, 0), b3, voffB); PG8_STAGE(PG8_SB(1, 1), b3 + hstep, voffB); PG8_STAGE(PG8_SA(1, 0), a3, voffA);
            PG8_WAIT_V(8); PG8_WAIT_L(0); PG8_BAR; PG8_MMA(1, 0, At, B0); PG8_MMA(1, 1, At, B1); PG8_BAR; PG8_SCHED;
            } else {
            PG8_LDB(B0, 0, 0); PG8_SCHED; PG8_LDA(At, 0, 0); PG8_STAGE(PG8_SA(1, 1), a1 + hstep, voffA);
            PG8_WAIT_L(8); PG8_BAR; PG8_WAIT_L(0); PG8_MMA(0, 0, At, B0); PG8_BAR; PG8_SCHED;
            PG8_LDB(B1, 0, 1); PG8_STAGE(PG8_SB(0, 0), b2, voffB);
            PG8_BAR; PG8_WAIT_L(0); PG8_MMA(0, 1, At, B1); PG8_BAR;
            PG8_LDA(At, 0, 1); PG8_STAGE(PG8_SA(0, 0), a2, voffA);
            PG8_BAR; PG8_WAIT_L(0); PG8_MMA(1, 0, At, B0); PG8_BAR; PG8_SCHED;
            PG8_STAGE(PG8_SB(0, 1), b2 + hstep, voffB);
            PG8_WAIT_V(6); PG8_BAR; PG8_MMA(1, 1, At, B1); PG8_BAR;
            PG8_LDB(B0, 1, 0); PG8_SCHED; PG8_LDA(At, 1, 0); PG8_STAGE(PG8_SA(0, 1), a2 + hstep, voffA);
            PG8_WAIT_L(8); PG8_BAR; PG8_WAIT_L(0); PG8_MMA(0, 0, At, B0); PG8_BAR; PG8_SCHED;
            PG8_LDB(B1, 1, 1); PG8_STAGE(PG8_SB(1, 0), b3, voffB);
            PG8_BAR; PG8_WAIT_L(0); PG8_MMA(0, 1, At, B1); PG8_BAR;
            PG8_LDA(At, 1, 1); PG8_STAGE(PG8_SA(1, 0), a3, voffA);
            PG8_BAR; PG8_WAIT_L(0); PG8_MMA(1, 0, At, B0); PG8_BAR; PG8_SCHED;
            PG8_STAGE(PG8_SB(1, 1), b3 + hstep, voffB);
            PG8_WAIT_V(6); PG8_BAR; PG8_MMA(1, 1, At, B1); PG8_BAR;
            }
        }
        if constexpr (ALIGN_EPI) { if (wr == 0) PG8_BAR; }
        if constexpr (!Epi::AFTER_DRAIN) { E(acc, cur, wr, wc, fr, fq); S.done(cur); }
        if (!has_next) break;
#pragma unroll
        for (int a = 0; a < 2; ++a)
#pragma unroll
            for (int b = 0; b < 2; ++b)
#pragma unroll
                for (int m = 0; m < 4; ++m)
#pragma unroll
                    for (int n = 0; n < 2; ++n) acc[a][b][m][n] = (f32x4){0.f, 0.f, 0.f, 0.f};
        cur = nxt; cA = nA; cB = nB; ++ui;
        if constexpr (ALIGN_EPI) { if (wr == 1) PG8_BAR; }
    }
    PG8_WAIT_V(0);
    if constexpr (!ALIGN_EPI) { if (wr == 0) PG8_BAR; }
    PG8_BAR;
    if constexpr (Epi::AFTER_DRAIN) { E.fused(acc, cur, wr, wc, fr, fq, lds, wid, lane); S.done(cur); }
#undef PG8_SA
#undef PG8_SB
#undef PG8_STAGE
#undef PG8_LDA
#undef PG8_LDB
#undef PG8_MMA
#undef PG8_WAIT_V
#undef PG8_WAIT_L
#undef PG8_BAR
#undef PG8_SCHED
}
}
namespace pg8 {
__device__ __forceinline__ float fast_sigmoid(float x) { return __builtin_amdgcn_rcpf(1.0f + __builtin_amdgcn_exp2f(-1.4426950408889634f * x)); }
__device__ __forceinline__ float row_rstd(const float* ssq, int row, int fq) {
    const f32x4* p = (const f32x4*)(ssq + (size_t)row * 32 + 8 * fq);
    const f32x4 a = p[0], b = p[1];
    float s = ((a[0] + a[1]) + (a[2] + a[3])) + ((b[0] + b[1]) + (b[2] + b[3]));
    s += __shfl_xor(s, 16); s += __shfl_xor(s, 32);
    return __builtin_amdgcn_rsqf(s * (1.0f / 1024.0f) + 1e-6f);
}
__device__ __forceinline__ u32x4 pack8(const f32x4 a, const f32x4 b) { u32x4 w; w.x = cvt_pk_bf16(a[0], a[1]); w.y = cvt_pk_bf16(a[2], a[3]); w.z = cvt_pk_bf16(b[0], b[1]); w.w = cvt_pk_bf16(b[2], b[3]); return w; }

struct EpiResid {
    static constexpr bool PERM = true, AFTER_DRAIN = false;
    const float* xold; float* xnew; bf16_t* xn; const float* gnext; float* ssq;
    __device__ __forceinline__ void operator()(const f32x4 (&acc)[2][2][4][2], const Unit& u, int wr, int wc, int fr, int fq) const {
        const int col0 = u.pn * BM + wc * 32 + 8 * fq;
#pragma unroll
        for (int ai = 0; ai < 2; ++ai)
#pragma unroll
            for (int m = 0; m < 4; ++m) {
                const int row = u.pm * BM + ai * HALF + wr * 64 + m * 16 + fr;
#pragma unroll
                for (int bj = 0; bj < 2; ++bj) {
                    const size_t off = (size_t)row * 1024 + col0 + bj * HALF;
                    const f32x4 x0 = *(const f32x4*)(xold + off) + acc[ai][bj][m][0], x1 = *(const f32x4*)(xold + off + 4) + acc[ai][bj][m][1];
                    *(f32x4*)(xnew + off) = x0; *(f32x4*)(xnew + off + 4) = x1;
                    float s = ((x0[0] * x0[0] + x0[1] * x0[1]) + (x0[2] * x0[2] + x0[3] * x0[3])) + ((x1[0] * x1[0] + x1[1] * x1[1]) + (x1[2] * x1[2] + x1[3] * x1[3]));
                    s += __shfl_xor(s, 16); s += __shfl_xor(s, 32);
                    if (fq == 0) ssq[(size_t)row * 32 + u.pn * 8 + bj * 4 + wc] = s;
                    if (gnext) { const f32x4 g0 = *(const f32x4*)(gnext + col0 + bj * HALF), g1 = *(const f32x4*)(gnext + col0 + bj * HALF + 4);
                        *(u32x4*)(xn + off) = pack8(x0 * g0, x1 * g1); }
                }
                if (m & 1) asm volatile("" ::: "memory");
            }
    }
};
struct EpiGluResid {
    static constexpr bool PERM = true, AFTER_DRAIN = false;
    const float* xold; float* xnew; bf16_t* xn; const float* gnext; float* ssq;
    __device__ __forceinline__ void operator()(const f32x4 (&acc)[2][2][4][2], const Unit& u, int wr, int wc, int fr, int fq) const {
        const int col0 = u.pn * HALF + wc * 32 + 8 * fq;
        const f32x4 g0 = *(const f32x4*)(gnext + col0), g1 = *(const f32x4*)(gnext + col0 + 4);
#pragma unroll
        for (int ai = 0; ai < 2; ++ai)
#pragma unroll
            for (int m = 0; m < 4; ++m) {
                const int row = u.pm * BM + ai * HALF + wr * 64 + m * 16 + fr;
                const size_t off = (size_t)row * 1024 + col0;
                f32x4 x0 = *(const f32x4*)(xold + off), x1 = *(const f32x4*)(xold + off + 4);
#pragma unroll
                for (int j = 0; j < 4; ++j) { x0[j] += acc[ai][0][m][0][j] * fast_sigmoid(acc[ai][1][m][0][j]); x1[j] += acc[ai][0][m][1][j] * fast_sigmoid(acc[ai][1][m][1][j]); }
                *(f32x4*)(xnew + off) = x0; *(f32x4*)(xnew + off + 4) = x1;
                float s = ((x0[0] * x0[0] + x0[1] * x0[1]) + (x0[2] * x0[2] + x0[3] * x0[3])) + ((x1[0] * x1[0] + x1[1] * x1[1]) + (x1[2] * x1[2] + x1[3] * x1[3]));
                s += __shfl_xor(s, 16); s += __shfl_xor(s, 32);
                if (fq == 0) ssq[(size_t)row * 32 + u.pn * 4 + wc] = s;
                *(u32x4*)(xn + off) = pack8(x0 * g0, x1 * g1);
                if (m & 1) asm volatile("" ::: "memory");
            }
    }
};
struct EpiSwiglu {
    static constexpr bool PERM = true, AFTER_DRAIN = false;
    bf16_t* H; const float* ssq;
    __device__ __forceinline__ void operator()(const f32x4 (&acc)[2][2][4][2], const Unit& u, int wr, int wc, int fr, int fq) const {
        const int col0 = u.pn * HALF + wc * 32 + 8 * fq;
#pragma unroll
        for (int ai = 0; ai < 2; ++ai)
#pragma unroll
            for (int m = 0; m < 4; ++m) {
                const int row = u.pm * BM + ai * HALF + wr * 64 + m * 16 + fr;
                const float rs = row_rstd(ssq, row, fq);
                f32x4 h0, h1;
#pragma unroll
                for (int j = 0; j < 4; ++j) { const float ga = acc[ai][0][m][0][j] * rs, gb = acc[ai][0][m][1][j] * rs;
                    h0[j] = ga * fast_sigmoid(ga) * (acc[ai][1][m][0][j] * rs); h1[j] = gb * fast_sigmoid(gb) * (acc[ai][1][m][1][j] * rs); }
                *(u32x4*)(H + (size_t)row * 2816 + col0) = pack8(h0, h1);
                asm volatile("" ::: "memory");
            }
    }
};
struct EpiGlaIn {
    static constexpr bool PERM = true, AFTER_DRAIN = false;
    bf16_t* Q; float* LA; const float* ba; const float* ssq;
    __device__ __forceinline__ void operator()(const f32x4 (&acc)[2][2][4][2], const Unit& u, int wr, int wc, int fr, int fq) const {
        const int pn = u.pn; const int cw = wc * 32 + 8 * fq;
        const size_t eoff = (pn < 2) ? (size_t)0 : ((pn < 4) ? (size_t)8388608 : ((pn < 8) ? (size_t)16777216 : (size_t)33554432));
        const int ld = (pn < 4) ? 512 : 1024; const int c0 = ((pn < 4) ? (pn & 1) : (pn & 3)) * 256; const float sc = (pn < 2) ? 0.08838834764831845f : 1.0f;
        bf16_t* base = Q + eoff;
#pragma unroll
        for (int ai = 0; ai < 2; ++ai)
#pragma unroll
            for (int m = 0; m < 4; ++m) {
                const int row = u.pm * BM + ai * HALF + wr * 64 + m * 16 + fr;
                asm volatile("" ::: "memory");
                const float rs = row_rstd(ssq, row, fq) * sc;
#pragma unroll
                for (int bj = 0; bj < 2; ++bj) {
                    f32x4 v0 = acc[ai][bj][m][0] * rs, v1 = acc[ai][bj][m][1] * rs;
                    if (pn >= 12) {
                        const int c = (pn - 12) * 256 + bj * HALF + cw;
                        const f32x4 b0 = *(const f32x4*)(ba + c), b1 = *(const f32x4*)(ba + c + 4);
#pragma unroll
                        for (int j = 0; j < 4; ++j) { const float z0 = v0[j] + b0[j], z1 = v1[j] + b1[j];
                            v0[j] = (fminf(z0, 0.f) - __logf(1.0f + __expf(-fabsf(z0)))) * 0.0625f; v1[j] = (fminf(z1, 0.f) - __logf(1.0f + __expf(-fabsf(z1)))) * 0.0625f; }
                        float* o = LA + (size_t)row * 512 + c; *(f32x4*)o = v0; *(f32x4*)(o + 4) = v1;
                    } else {
                        if (pn >= 8) {
#pragma unroll
                            for (int j = 0; j < 4; ++j) { v0[j] = v0[j] * fast_sigmoid(v0[j]); v1[j] = v1[j] * fast_sigmoid(v1[j]); } }
                        *(u32x4*)(base + (size_t)row * ld + c0 + bj * HALF + cw) = pack8(v0, v1);
                    }
                }
            }
    }
};
struct EpiDiffQkv {
    static constexpr bool PERM = true, AFTER_DRAIN = false;
    bf16_t* Q; const int* pos; const float* ssq;
    __device__ __forceinline__ void operator()(const f32x4 (&acc)[2][2][4][2], const Unit& u, int wr, int wc, int fr, int fq) const {
        const int pn = u.pn; const int cw = wc * 32 + 8 * fq;
        bf16_t* base = Q + (size_t)(pn >> 2) * 16777216; const int c0 = (pn & 3) * 256;
        const float sc = pn < 4 ? 0.18033688011112042f : 1.0f;
        const bool rope = (pn < 8) && ((wc & 1) == 0);
        const double IF[8] = {0.15915494309189535, 0.03086376340470123, 0.005985185712713705, 0.001160663641240061, 0.00022507907903927653, 4.364795279280289e-05, 8.464330808241401e-06, 1.6414262627950345e-06};
#pragma unroll
        for (int ai = 0; ai < 2; ++ai)
#pragma unroll
            for (int m = 0; m < 4; ++m) {
                const int row = u.pm * BM + ai * HALF + wr * 64 + m * 16 + fr;
                asm volatile("" ::: "memory");
                const float rs = row_rstd(ssq, row, fq) * sc;
                float cs[8], sn[8];
                if (rope) { const double p = (double)pos[row];
#pragma unroll
                    for (int i = 0; i < 8; ++i) { const double r = p * IF[i]; const float f = (float)(r - __builtin_floor(r)); cs[i] = __builtin_amdgcn_cosf(f); sn[i] = __builtin_amdgcn_sinf(f); } }
#pragma unroll
                for (int bj = 0; bj < 2; ++bj) {
                    f32x4 v0 = acc[ai][bj][m][0] * rs, v1 = acc[ai][bj][m][1] * rs;
                    if (rope) {
#pragma unroll
                        for (int j = 0; j < 4; ++j) {
                            const float o0 = __shfl_xor(v0[j], 16), o1 = __shfl_xor(v1[j], 16);
                            if (fq == 0) { v0[j] = v0[j] * cs[j] - o0 * sn[j]; v1[j] = v1[j] * cs[4 + j] - o1 * sn[4 + j]; }
                            else if (fq == 1) { v0[j] = v0[j] * cs[j] + o0 * sn[j]; v1[j] = v1[j] * cs[4 + j] + o1 * sn[4 + j]; }
                        }
                    }
                    *(u32x4*)(base + (size_t)row * 1024 + c0 + bj * HALF + cw) = pack8(v0, v1);
                }
            }
    }
};
}
namespace attn_body {
using bf16=__hip_bfloat16;
using bf16x8=__attribute__((ext_vector_type(8)))short;
using s16x4=__attribute__((ext_vector_type(4)))short;
using f32x16=__attribute__((ext_vector_type(16)))float;
using u32x4=__attribute__((ext_vector_type(4)))unsigned;
constexpr int BATCH=1,NHEAD=16,SEQ=16384,D=64,DM=NHEAD*D;
constexpr int NW=8,QBLK=32,QB=QBLK*NW,KVBLK=64,NQB=SEQ/QB;
constexpr int ATTN_PITCH=DM, ATTN_UNIT_ROWS=QB;
__device__ __forceinline__ int crow(int r,int hi){return (r&3)+8*(r>>2)+4*hi;}
#define SBAR() __builtin_amdgcn_sched_barrier(0)
__device__ __forceinline__ void cmask(f32x16&p0,f32x16&p1,int jb,int qrel,int hi){
  const float NEG=-INFINITY; (void)hi;
  if(jb>(qrel>>6)){
  #pragma unroll
  for(int r=0;r<16;++r){p0[r]=NEG;p1[r]=NEG;}}
}

constexpr int NSLOT=3, SLOTB=8192;
constexpr int LDS_K=0, LDS_V=NSLOT*SLOTB, LDS_WS=2*NSLOT*SLOTB, LDS_OST=LDS_WS+NW*64*4, LDS_BYTES=LDS_OST+NW*4096;
constexpr float C2=0.125f*1.4426950408889634f;
__device__ __forceinline__ void glds16(const void*gsrc,unsigned lds_dst){unsigned keep;
  asm volatile("s_mov_b32 %0, m0\n\ts_mov_b32 m0, %2\n\ts_nop 0\n\tglobal_load_lds_dwordx4 %1, off\n\ts_mov_b32 m0, %0":"=&s"(keep):"v"(gsrc),"s"(lds_dst):"memory");}
__device__ __forceinline__ float max3f(float a,float b,float c){float r;asm("v_max3_f32 %0, %1, %2, %3":"=v"(r):"v"(a),"v"(b),"v"(c));return r;}
__device__ __forceinline__ float max2f(float a,float b){float r;asm("v_max_f32_e32 %0, %1, %2":"=v"(r):"v"(a),"v"(b));return r;}
__device__ __forceinline__ float fadd_s(float a,float b){float r;asm("v_add_f32_e32 %0, %1, %2":"=v"(r):"v"(a),"v"(b));return r;}
__device__ __forceinline__ float fsub_s(float a,float b){float r;asm("v_sub_f32_e32 %0, %1, %2":"=v"(r):"v"(a),"v"(b));return r;}
typedef float f32x2_t __attribute__((ext_vector_type(2))); typedef __bf16 bf16x2_t __attribute__((ext_vector_type(2)));
__device__ __forceinline__ unsigned cvtpk_s(float lo,float hi){f32x2_t v={lo,hi};bf16x2_t b=__builtin_convertvector(v,bf16x2_t);return __builtin_bit_cast(unsigned,b);}
#define WAIT_BAR(N) asm volatile("s_waitcnt vmcnt(" #N ") lgkmcnt(0)\n\ts_barrier":::"memory")

__device__ __forceinline__ void qkt(f32x16&p0,f32x16&p1,const char*Kslot,const bf16x8*qr,const f32x16&negm,int r32,int hi){
  const char*kb=Kslot+hi*1024+r32*16;
  #pragma unroll
  for(int d0=0;d0<4;++d0){
    const bf16x8 b0=*reinterpret_cast<const bf16x8*>(kb+d0*2048);
    const bf16x8 b1=*reinterpret_cast<const bf16x8*>(kb+d0*2048+512);
    if(d0==0){p0=__builtin_amdgcn_mfma_f32_32x32x16_bf16(b0,qr[0],negm,0,0,0);p1=__builtin_amdgcn_mfma_f32_32x32x16_bf16(b1,qr[0],negm,0,0,0);}
    else{p0=__builtin_amdgcn_mfma_f32_32x32x16_bf16(b0,qr[d0],p0,0,0,0);p1=__builtin_amdgcn_mfma_f32_32x32x16_bf16(b1,qr[d0],p1,0,0,0);}}
}
typedef __attribute__((address_space(3))) const char* lds_cptr;
typedef short v4i16_t __attribute__((ext_vector_type(4)));
__device__ __forceinline__ void kload8(bf16x8*kf,lds_cptr kp){
  kf[0]=*(const __attribute__((address_space(3))) bf16x8*)(kp);      kf[1]=*(const __attribute__((address_space(3))) bf16x8*)(kp+512);
  kf[2]=*(const __attribute__((address_space(3))) bf16x8*)(kp+2048); kf[3]=*(const __attribute__((address_space(3))) bf16x8*)(kp+2560);
  kf[4]=*(const __attribute__((address_space(3))) bf16x8*)(kp+4096); kf[5]=*(const __attribute__((address_space(3))) bf16x8*)(kp+4608);
  kf[6]=*(const __attribute__((address_space(3))) bf16x8*)(kp+6144); kf[7]=*(const __attribute__((address_space(3))) bf16x8*)(kp+6656);
}
__device__ __forceinline__ void kload2(bf16x8*kf,lds_cptr kp,int j){ kf[2*j]=*(const __attribute__((address_space(3))) bf16x8*)(kp+j*2048); kf[2*j+1]=*(const __attribute__((address_space(3))) bf16x8*)(kp+j*2048+512); }
__device__ __forceinline__ s16x4 vtr(lds_cptr p){ return __builtin_bit_cast(s16x4,__builtin_amdgcn_ds_read_tr16_b64_v4i16((__attribute__((address_space(3))) v4i16_t*)p)); }
__device__ __forceinline__ float rowmax(const f32x16&p0,const f32x16&p1){
  float a=max3f(p0[0],p0[1],p1[0]),b=max3f(p0[2],p0[3],p1[1]);a=max3f(a,p1[2],p1[3]);
  #pragma unroll
  for(int r=4;r<16;r+=4){a=max3f(a,p0[r],p0[r+1]);b=max3f(b,p0[r+2],p0[r+3]);a=max3f(a,p1[r],p1[r+1]);b=max3f(b,p1[r+2],p1[r+3]);}
  const float m=max2f(a,b);
  auto rr=__builtin_amdgcn_permlane32_swap(__float_as_uint(m),__float_as_uint(m),false,false);
  return max2f(__uint_as_float(rr[0]),__uint_as_float(rr[1]));
}
__device__ __forceinline__ void pv(f32x16*o,int vb,bf16x8 pa0,bf16x8 pa1,bf16x8 pa2,bf16x8 pa3){
  #pragma unroll
  for(int d0=0;d0<2;++d0){s16x4 lo[4],hi[4];
    #pragma unroll
    for(int ks=0;ks<4;++ks){
      asm volatile("ds_read_b64_tr_b16 %0,%1 offset:%c2":"=&v"(lo[ks]):"v"(vb),"i"(d0*4096+ks*1024):"memory");
      asm volatile("ds_read_b64_tr_b16 %0,%1 offset:%c2":"=&v"(hi[ks]):"v"(vb),"i"(d0*4096+ks*1024+512):"memory");}
    asm volatile("s_waitcnt lgkmcnt(0)":::"memory");SBAR();
    #define PK(k) (bf16x8){lo[k][0],lo[k][1],lo[k][2],lo[k][3],hi[k][0],hi[k][1],hi[k][2],hi[k][3]}
    o[d0]=__builtin_amdgcn_mfma_f32_32x32x16_bf16(pa0,PK(0),o[d0],0,0,0);
    o[d0]=__builtin_amdgcn_mfma_f32_32x32x16_bf16(pa1,PK(1),o[d0],0,0,0);
    o[d0]=__builtin_amdgcn_mfma_f32_32x32x16_bf16(pa2,PK(2),o[d0],0,0,0);
    o[d0]=__builtin_amdgcn_mfma_f32_32x32x16_bf16(pa3,PK(3),o[d0],0,0,0);
    #undef PK
  }
}

#ifndef ATTN_STORE16
#define ATTN_STORE16(p,v) (*(u32x4*)(p)=(v))
#endif
template<int THRL> __device__ __forceinline__ void attn_unit(int qb,const bf16*Qh,const bf16*__restrict__ Kh,const bf16*__restrict__ Vh,bf16*Oh,int opitch,char*shm){
  int tid_=threadIdx.x; asm volatile("":"+v"(tid_)); const int tid=tid_,lane=tid&63,r32=lane&31,hi=lane>>5; const int wid=__builtin_amdgcn_readfirstlane(tid>>6);
  const int q0=qb*QB;
  const bf16*Qw=Qh+(long)(q0+wid*QBLK)*DM;
  const unsigned lds0=(unsigned)(uintptr_t)shm;
  float*wsf=(float*)(shm+LDS_WS)+wid*64;
  const bf16*ksrc=Kh+(long)lane*DM+wid*8;
  const bf16*vsrc=Vh+(long)(16*(wid&3)+(lane>>2))*DM+(wid>>2)*32+(lane&3)*8;
  const unsigned kdst=lds0+LDS_K+wid*1024, vdst=lds0+LDS_V+wid*1024;
  #define DMA_K(t,slot) glds16(ksrc+(long)(t)*KVBLK*DM,(unsigned)__builtin_amdgcn_readfirstlane(kdst+(slot)))
  #define DMA_V(t,slot) glds16(vsrc+(long)(t)*KVBLK*DM,(unsigned)__builtin_amdgcn_readfirstlane(vdst+(slot)))
  const int vb0=(int)(lds0+LDS_V)+((lane>>4)&1)*32+(lane&3)*8+(4*hi+((lane&15)>>2))*64;
  const char*Kbase=shm+LDS_K; bf16x8 kf[8];
  const lds_cptr shm3=(lds_cptr)shm; const lds_cptr kp0=shm3+LDS_K+hi*1024+r32*16; const lds_cptr vp0=shm3+LDS_V+((lane>>4)&1)*32+(lane&3)*8+(4*hi+((lane&15)>>2))*64;
  const int NT=(q0+QB)/KVBLK;
  DMA_K(0,0);DMA_V(0,0);DMA_K(1,SLOTB);
  bf16x8 qr[4];
  #pragma unroll
  for(int d0=0;d0<4;++d0)qr[d0]=*reinterpret_cast<const bf16x8*>(&Qw[(long)r32*DM+d0*16+hi*8]);
  float mhat=0.f,l_reg=0.f;f32x16 o[2];o[0]=f32x16{};o[1]=f32x16{};f32x16 negm=f32x16{};asm volatile("":"+v"(negm));
  const int qrel=wid*QBLK+r32;
  #define CMASK(P0,P1,t) do{int jb_=(t)-(NT-4); if(jb_>=0)cmask(P0,P1,jb_,qrel,hi);}while(0)
  bool resc=false;
  #define START(P0,P1) do{ const float rm=rowmax(P0,P1); resc=false; \
    { const float dl=rm; mhat=fadd_s(mhat,dl); \
      _Pragma("unroll") for(int r=0;r<16;++r){P0[r]=fsub_s(P0[r],dl);P1[r]=fsub_s(P1[r],dl);} \
      _Pragma("unroll") for(int r=0;r<16;++r)negm[r]=-mhat; asm volatile("":"+v"(negm)); } \
    _Pragma("unroll") for(int r=0;r<16;++r)P0[r]=__builtin_amdgcn_exp2f(P0[r]); }while(0)
  #define RESC() do{ if(resc){ asm volatile("s_waitcnt lgkmcnt(0)":::"memory"); \
      _Pragma("unroll") for(int d_=0;d_<2;++d_) _Pragma("unroll") for(int r=0;r<16;++r)o[d_][r]*=wsf[crow(r,hi)]; } }while(0)
  f32x16 pA0,pA1,pB0,pB1;
  int sl_prev=0,sl_cur=0,sl_next=SLOTB;
  #define ROT() do{sl_prev=sl_cur;sl_cur=sl_next;sl_next=(sl_next==(NSLOT-1)*SLOTB)?0:sl_next+SLOTB;}while(0)
  DMA_K(2,2*SLOTB);
  WAIT_BAR(3);
  qkt(pA0,pA1,Kbase,qr,negm,r32,hi);asm volatile("s_nop 15\n\ts_nop 7":"+v"(pA0),"+v"(pA1));CMASK(pA0,pA1,0);
  START(pA0,pA1);
  _Pragma("unroll") for(int r=0;r<16;++r)pA1[r]=__builtin_amdgcn_exp2f(pA1[r]);
  WAIT_BAR(0);
  DMA_K(3,0);DMA_V(1,SLOTB);
  ROT();
  kload8(kf,kp0+sl_cur);
  WAIT_BAR(2);
  s16x4 vlo[8],vhi[8]; u32x4 pw0,pw1,pw2,pw3;
  #define PKW(P,B) cvtpk_s(P[B],P[B+1])
  #define PAF(k) __builtin_bit_cast(bf16x8,pw##k)
  #define VFR(i) (bf16x8){vlo[i][0],vlo[i][1],vlo[i][2],vlo[i][3],vhi[i][0],vhi[i][1],vhi[i][2],vhi[i][3]}
  #define PIN(x) asm volatile("":"+v"(x))
  #define MX3(a,b,c) __builtin_fmaxf(__builtin_fmaxf((a),(b)),(c))
  #define GAPA(MF,A0,A1,A2,A3,W0,W1,PW) do{ MF; sacc+=A0; sacc+=A1; sacc+=A2; sacc+=A3; PIN(sacc); W0; W1; PIN(PW); SBAR(); }while(0)
  #define EX(v) __builtin_amdgcn_exp2f(v)
  #define GAPB(MF,X,B) do{ MF; X[B]=EX(X[B]); X[B+1]=EX(X[B+1]); X[B+2]=EX(X[B+2]); X[B+3]=EX(X[B+3]); PIN(X); SBAR(); }while(0)
  #define VRD(i) do{ vlo[i]=vtr(vp_+(((i)>>2)*4096+((i)&3)*1024)); vhi[i]=vtr(vp_+(((i)>>2)*4096+((i)&3)*1024+512)); }while(0)
  #define KRD(G,j) do{ if(G){ kload2(kf,kp0+sl_next,j); SBAR(); } }while(0)
  #define STEP(C0,C1,P0,P1,t,GK,GV,GL) do{ SBAR(); \
    const lds_cptr vp_=vp0+sl_prev; \
    VRD(0); SBAR(); float sacc=(P0[0]+P0[1]); \
    GAPA(C0=__builtin_amdgcn_mfma_f32_32x32x16_bf16(kf[0],qr[0],negm,0,0,0), P0[2],P0[3],P0[4],P0[5],     pw0[0]=PKW(P0,0), pw0[1]=PKW(P0,2), pw0); \
    VRD(4); SBAR(); GAPA(C1=__builtin_amdgcn_mfma_f32_32x32x16_bf16(kf[1],qr[0],negm,0,0,0), P0[6],P0[7],P0[8],P0[9],     pw0[2]=PKW(P0,4), pw0[3]=PKW(P0,6), pw0); \
    VRD(1); SBAR(); GAPA(C0=__builtin_amdgcn_mfma_f32_32x32x16_bf16(kf[2],qr[1],C0,0,0,0),   P0[10],P0[11],P0[12],P0[13], pw1[0]=PKW(P0,8), pw1[1]=PKW(P0,10), pw1); \
    VRD(5); SBAR(); GAPA(C1=__builtin_amdgcn_mfma_f32_32x32x16_bf16(kf[3],qr[1],C1,0,0,0),   P0[14],P0[15],P1[0],P1[1],   pw1[2]=PKW(P0,12),pw1[3]=PKW(P0,14), pw1); \
    VRD(2); SBAR(); GAPA(C0=__builtin_amdgcn_mfma_f32_32x32x16_bf16(kf[4],qr[2],C0,0,0,0),   P1[2],P1[3],P1[4],P1[5],     pw2[0]=PKW(P1,0), pw2[1]=PKW(P1,2), pw2); \
    VRD(6); SBAR(); GAPA(C1=__builtin_amdgcn_mfma_f32_32x32x16_bf16(kf[5],qr[2],C1,0,0,0),   P1[6],P1[7],P1[8],P1[9],     pw2[2]=PKW(P1,4), pw2[3]=PKW(P1,6), pw2); \
    VRD(3); SBAR(); GAPA(C0=__builtin_amdgcn_mfma_f32_32x32x16_bf16(kf[6],qr[3],C0,0,0,0),   P1[10],P1[11],P1[12],P1[13], pw3[0]=PKW(P1,8), pw3[1]=PKW(P1,10), pw3); \
    VRD(7); SBAR(); GAPA(C1=__builtin_amdgcn_mfma_f32_32x32x16_bf16(kf[7],qr[3],C1,0,0,0),   P1[14],P1[15],0.f,0.f,       pw3[2]=PKW(P1,12),pw3[3]=PKW(P1,14), pw3); \
    l_reg+=sacc; \
    if(GK){DMA_K((t)+3,sl_cur);} if(GV){DMA_V((t)+1,sl_next);} \
    CMASK(C0,C1,t); \
    { float a=MX3(C0[0],C0[1],C1[0]),b=MX3(C0[2],C0[3],C1[1]); a=MX3(a,C1[2],C1[3]); \
      _Pragma("unroll") for(int r=4;r<16;r+=4){a=MX3(a,C0[r],C0[r+1]);b=MX3(b,C0[r+2],C0[r+3]);a=MX3(a,C1[r],C1[r+1]);b=MX3(b,C1[r+2],C1[r+3]);} \
      float rm=__builtin_fmaxf(a,b); { auto rr=__builtin_amdgcn_permlane32_swap(__float_as_uint(rm),__float_as_uint(rm),false,false); rm=__builtin_fmaxf(__uint_as_float(rr[0]),__uint_as_float(rr[1])); } \
      resc=false; \
      if(__builtin_expect(__any(rm>(float)THRL),0)){ const float dl=__builtin_fmaxf(rm,0.f); mhat+=dl; \
        _Pragma("unroll") for(int r=0;r<16;++r){C0[r]-=dl;C1[r]-=dl;} \
        _Pragma("unroll") for(int r=0;r<16;++r)negm[r]=-mhat; asm volatile("":"+v"(negm)); \
        const float f=__builtin_amdgcn_exp2f(-dl); l_reg*=f; if(hi==0)wsf[r32]=f; resc=true; } } \
    SBAR(); \
    GAPB(o[0]=__builtin_amdgcn_mfma_f32_32x32x16_bf16(PAF(0),VFR(0),o[0],0,0,0), C0,0); \
    GAPB(o[1]=__builtin_amdgcn_mfma_f32_32x32x16_bf16(PAF(0),VFR(4),o[1],0,0,0), C0,4); \
    KRD(GL,0); GAPB(o[0]=__builtin_amdgcn_mfma_f32_32x32x16_bf16(PAF(1),VFR(1),o[0],0,0,0), C0,8); \
    KRD(GL,1); GAPB(o[1]=__builtin_amdgcn_mfma_f32_32x32x16_bf16(PAF(1),VFR(5),o[1],0,0,0), C0,12); \
    KRD(GL,2); GAPB(o[0]=__builtin_amdgcn_mfma_f32_32x32x16_bf16(PAF(2),VFR(2),o[0],0,0,0), C1,0); \
    KRD(GL,3); GAPB(o[1]=__builtin_amdgcn_mfma_f32_32x32x16_bf16(PAF(2),VFR(6),o[1],0,0,0), C1,4); \
    GAPB(o[0]=__builtin_amdgcn_mfma_f32_32x32x16_bf16(PAF(3),VFR(3),o[0],0,0,0), C1,8); \
    GAPB(o[1]=__builtin_amdgcn_mfma_f32_32x32x16_bf16(PAF(3),VFR(7),o[1],0,0,0), C1,12); \
    }while(0)
  int t=1;
  #undef CMASK
  #define CMASK(P0,P1,t) do{}while(0)
  for(;t+5<NT;t+=2){
    STEP(pB0,pB1,pA0,pA1,t,true,true,true);     WAIT_BAR(2); RESC(); ROT();
    STEP(pA0,pA1,pB0,pB1,t+1,true,true,true);   WAIT_BAR(2); RESC(); ROT();
  }
  #undef CMASK
  #define CMASK(P0,P1,t) do{int jb_=(t)-(NT-4); if(jb_>=0)cmask(P0,P1,jb_,qrel,hi);}while(0)
  #define ENDW(tt) do{ if((tt)+3<NT){WAIT_BAR(2);} else if((tt)+2<NT){WAIT_BAR(1);} else {WAIT_BAR(0);} }while(0)
  for(;t+1<NT;t+=2){
    STEP(pB0,pB1,pA0,pA1,t,(t+3<NT),(t+1<NT),(t+1<NT));       ENDW(t);   RESC(); ROT();
    STEP(pA0,pA1,pB0,pB1,t+1,(t+4<NT),(t+2<NT),(t+2<NT));     ENDW(t+1); RESC(); ROT();
  }
  STEP(pB0,pB1,pA0,pA1,NT-1,false,false,false); RESC();
  { float sacc=pB0[0]+pB0[1]; _Pragma("unroll") for(int r=2;r<16;++r)sacc+=pB0[r]; _Pragma("unroll") for(int r=0;r<16;++r)sacc+=pB1[r]; l_reg+=sacc;
    pw0=(u32x4){PKW(pB0,0),PKW(pB0,2),PKW(pB0,4),PKW(pB0,6)};pw1=(u32x4){PKW(pB0,8),PKW(pB0,10),PKW(pB0,12),PKW(pB0,14)};pw2=(u32x4){PKW(pB1,0),PKW(pB1,2),PKW(pB1,4),PKW(pB1,6)};pw3=(u32x4){PKW(pB1,8),PKW(pB1,10),PKW(pB1,12),PKW(pB1,14)};
    SBAR(); pv(o,vb0+sl_cur,PAF(0),PAF(1),PAF(2),PAF(3)); }
  #undef PKW
  #undef PAF
  #undef VFR
  #undef PIN
  #undef MX3
  #undef GAPA
  #undef GAPB
  #undef EX
  #undef VRD
  #undef KRD
  #undef STEP
  #undef ENDW
  {auto rr=__builtin_amdgcn_permlane32_swap(__float_as_uint(l_reg),__float_as_uint(l_reg),false,false);l_reg=__uint_as_float(rr[0])+__uint_as_float(rr[1]);}
  if(hi==0)wsf[32+r32]=l_reg;asm volatile("s_waitcnt lgkmcnt(0)":::"memory");
  float rli[16];
  #pragma unroll
  for(int r=0;r<16;++r)rli[r]=__builtin_amdgcn_rcpf(wsf[32+crow(r,hi)]);
  bf16*Ow=Oh+(long)(q0+wid*QBLK)*opitch;
  { bf16*stg=(bf16*)(shm+LDS_OST)+wid*2048;
    #pragma unroll
    for(int r=0;r<16;++r){const int orow=crow(r,hi);
      #pragma unroll
      for(int d0=0;d0<2;++d0)stg[orow*64+d0*32+r32]=__float2bfloat16(o[d0][r]*rli[r]);}
    asm volatile("s_waitcnt lgkmcnt(0)":::"memory");
    #pragma unroll
    for(int i=0;i<4;++i){const int row=i*8+(lane>>3),ch=lane&7; const u32x4 v=*(const u32x4*)(stg+row*64+ch*8); ATTN_STORE16(Ow+(long)row*opitch+ch*8,v);} }
  asm volatile("s_waitcnt lgkmcnt(0)\n\ts_barrier":::"memory");
  #undef DMA_K
  #undef DMA_V
  #undef CMASK
  #undef START
  #undef RESC
  #undef ROT
}
constexpr int ATTN_LDS_BYTES=LDS_BYTES;
struct AttnTensors { const bf16* Q; const bf16* K; const bf16* V; bf16* O; };
struct AttnUnit { int bh; int qb; };
struct StaticOrder {
  int vcu;
  __device__ __forceinline__ explicit StaticOrder(int grid,int block):vcu((block%8)*(grid/8)+block/8){}
  __device__ __forceinline__ bool next(int i,AttnUnit&u)const{ if(i>=8)return false; const int s=vcu&7; u.bh=vcu>>3; const int ii=7-i; u.qb=(ii&1)?(16*(ii>>1)+15-s):(16*(ii>>1)+s); return true; }
  __device__ __forceinline__ void a_ready(const AttnUnit&)const{}
  __device__ __forceinline__ void done(const AttnUnit&)const{}
};
template<class Sched,int THRL=8> __device__ __forceinline__ void attn_phase(char*lds,const AttnTensors&T,const Sched&S){
  AttnUnit u;
  for(int i=0;S.next(i,u);++i){ const int j=u.bh>>1,hf=u.bh&1; attn_unit<THRL>(u.qb,T.Q+64*j,T.K+64*j,T.V+128*(j>>1)+64*hf,T.O+128*j+64*hf,2048,lds); }
}
#undef SBAR
#undef WAIT_BAR
}
#define GAS __attribute__((address_space(1)))
#define LAS __attribute__((address_space(3)))
typedef unsigned short bf16;
typedef unsigned v4u __attribute__((ext_vector_type(4)));
typedef unsigned v2u __attribute__((ext_vector_type(2)));
typedef float f32x4 __attribute__((ext_vector_type(4)));
typedef float f32x2 __attribute__((ext_vector_type(2)));
typedef short bf16x8 __attribute__((ext_vector_type(8)));
#define LDS_WAIT() asm volatile("s_waitcnt lgkmcnt(0)" ::: "memory")

constexpr int M = 16384, D = 1024, FF = 2816, NCHUNK = 256;
constexpr size_t MiB = 1u << 20;
constexpr size_t WS_WGU = 2 * MiB, WS_WD = 46 * MiB, WS_WGLU = 68 * MiB, WS_WIN = 76 * MiB, WS_WOG = 83 * MiB, WS_WQKV = 85 * MiB, WS_WOD = 91 * MiB;
constexpr size_t WS_S5P = 93 * MiB, WS_SSQ = 95 * MiB, WS_XN = 98 * MiB, WS_SCR = 130 * MiB, WS_END = 324 * MiB;
constexpr size_t S5P_LAM = 0, S5P_L64 = 32768, S5P_BB = 65536, S5P_CT = 65536 + 524288;
constexpr size_t SC_H = 0;
constexpr size_t SC_Z = 0, SC_SLOC = 32 * MiB, SC_CAR = 40 * MiB;
constexpr size_t SC_GQ = 0, SC_GK = 16 * MiB, SC_GV = 32 * MiB, SC_GSG = 64 * MiB, SC_GLA = 96 * MiB, SC_GUPD = 128 * MiB, SC_GDEC = 192 * MiB, SC_GO2 = SC_GV;
constexpr size_t SC_DQ = 0, SC_DK = 32 * MiB, SC_DV = 64 * MiB, SC_DO = 96 * MiB, SC_DOC = 160 * MiB;
static_assert(SC_GK == 16 * MiB && SC_GV == 32 * MiB && SC_GSG == 64 * MiB && SC_DK == 32 * MiB && SC_DV == 64 * MiB, "epilogue element offsets");
constexpr int LDS_BYTES = 147456;
constexpr int NWAVES = 8;
constexpr float LAMBDA_INIT = 0.4707130183435842f;

__device__ __forceinline__ unsigned f2bf(float f) { unsigned u = __builtin_bit_cast(unsigned, f); return (u + 0x7fffu + ((u >> 16) & 1u)) >> 16; }
__device__ __forceinline__ unsigned pk2(float lo, float hi) { return f2bf(lo) | (f2bf(hi) << 16); }
__device__ __forceinline__ float bf_lo(unsigned w) { return __builtin_bit_cast(float, w << 16); }
__device__ __forceinline__ float bf_hi(unsigned w) { return __builtin_bit_cast(float, w & 0xffff0000u); }
__device__ __forceinline__ float bf2f(bf16 b) { return __builtin_bit_cast(float, (unsigned)b << 16); }
__device__ __forceinline__ float wave_sum(float v) {
#pragma unroll
    for (int o = 1; o < 64; o <<= 1) v += __shfl_xor(v, o);
    return v;
}

struct Args {
    const float* x; const int* pos; const float *norm_mix, *norm_ffn, *norm_final;
    const float *s5_lam_re, *s5_lam_im, *s5_log_dt, *s5_b_re, *s5_b_im, *s5_c_re, *s5_c_im, *s5_d, *s5_w_glu;
    const float *gla_w_in, *gla_w_a2, *gla_b_a, *gla_norm, *gla_w_o;
    const float *diff_w_qkv, *diff_lq1, *diff_lk1, *diff_lq2, *diff_lk2, *diff_subln, *diff_w_o;
    const float *ffn_w_gu, *ffn_w_d;
    float* out; unsigned char* ws;
};

#define KA(f) (*(volatile const __attribute__((address_space(4))) decltype(Args::f)*)((const __attribute__((address_space(4))) char*)__builtin_amdgcn_kernarg_segment_ptr() + offsetof(Args, f)))
__device__ __forceinline__ void transpose_item(const float* W, int ldw, int K, bf16* WT, int k0, int n0, int drow0, LAS float* scr, int lane) {
#pragma unroll 8
    for (int i = 0; i < 32; ++i) { const int kk = 2 * i + (lane >> 5); scr[kk * 33 + (lane & 31)] = W[(size_t)(k0 + kk) * ldw + n0 + (lane & 31)]; }
    LDS_WAIT();
    const int c = lane & 7;
#pragma unroll
    for (int j = 0; j < 4; ++j) { const int n = (lane >> 3) + 8 * j; const LAS float* s = scr + (8 * c) * 33 + n;
        v4u o; o.x = pk2(s[0 * 33], s[1 * 33]); o.y = pk2(s[2 * 33], s[3 * 33]); o.z = pk2(s[4 * 33], s[5 * 33]); o.w = pk2(s[6 * 33], s[7 * 33]);
        *(v4u*)(WT + (size_t)(drow0 + n) * K + k0 + 8 * c) = o; }
    LDS_WAIT();
}

__device__ __forceinline__ void prologue(LAS unsigned char* lds, int tid, int lane, int wave) {
    unsigned char* ws = KA(ws);
    LAS float* scr = (LAS float*)(lds + wave * 16384);
    const int gw = blockIdx.x * NWAVES + wave, NGW = gridDim.x * NWAVES;
    constexpr int I_GU = 16 * 176, I_D = 44 * 32, I_GLU = 16 * 64, I_IN = 16 * 96, I_SQ = 16 * 32, I_QKV = 16 * 96;
    constexpr int NITEMS = 4 * I_GU + 4 * I_D + 2 * I_GLU + I_IN + I_SQ + I_QKV + I_SQ;
    for (int it = gw; it < NITEMS; it += NGW) {
        int r = it; const float* W; bf16* WT; int ldw, K, ncols, inter = 0;
        if (r < 4 * I_GU) { const int L = r / I_GU; r -= L * I_GU; W = KA(ffn_w_gu) + (size_t)L * 1024 * 5632; WT = (bf16*)(ws + WS_WGU) + (size_t)L * 5632 * 1024; ldw = 5632; K = 1024; ncols = 5632; inter = 2816; }
        else if ((r -= 4 * I_GU) < 4 * I_D) { const int L = r / I_D; r -= L * I_D; W = KA(ffn_w_d) + (size_t)L * 2816 * 1024; WT = (bf16*)(ws + WS_WD) + (size_t)L * 1024 * 2816; ldw = 1024; K = 2816; ncols = 1024; }
        else if ((r -= 4 * I_D) < 2 * I_GLU) { const int L = r / I_GLU; r -= L * I_GLU; W = KA(s5_w_glu) + (size_t)L * 1024 * 2048; WT = (bf16*)(ws + WS_WGLU) + (size_t)L * 2048 * 1024; ldw = 2048; K = 1024; ncols = 2048; inter = 1024; }
        else if ((r -= 2 * I_GLU) < I_IN) { W = KA(gla_w_in); WT = (bf16*)(ws + WS_WIN); ldw = 3088; K = 1024; ncols = 3072; }
        else if ((r -= I_IN) < I_SQ) { W = KA(gla_w_o); WT = (bf16*)(ws + WS_WOG); ldw = 1024; K = 1024; ncols = 1024; }
        else if ((r -= I_SQ) < I_QKV) { W = KA(diff_w_qkv); WT = (bf16*)(ws + WS_WQKV); ldw = 3072; K = 1024; ncols = 3072; }
        else { r -= I_QKV; W = KA(diff_w_o); WT = (bf16*)(ws + WS_WOD); ldw = 1024; K = 1024; ncols = 1024; }
        const int nblk = ncols / 32, kb = r / nblk, nb = r - kb * nblk, n0 = nb * 32;
        int drow0 = n0;
        if (inter) { if (n0 < inter) drow0 = 256 * (n0 >> 7) + (n0 & 127); else { const int n1 = n0 - inter; drow0 = 256 * (n1 >> 7) + 128 + (n1 & 127); } }
        transpose_item(W, ldw, K, WT, kb * 64, n0, drow0, scr, lane);
    }
    {
        bf16* WT = (bf16*)(ws + WS_WIN) + (size_t)3072 * 1024;
        for (int e = blockIdx.x * 512 + tid; e < 512 * 1024; e += gridDim.x * 512) {
            const int k = e & 1023, j = e >> 10; float s = 0.f;
            const float* wi = KA(gla_w_in) + (size_t)k * 3088 + 3072;
#pragma unroll
            for (int r = 0; r < 16; ++r) s += wi[r] * KA(gla_w_a2)[r * 512 + j];
            WT[(size_t)j * 1024 + k] = (bf16)f2bf(s);
        }
    }
    {
        bf16* XN = (bf16*)(ws + WS_XN); float* SSQ = (float*)(ws + WS_SSQ);
        for (int m = gw; m < M; m += NGW) {
            const f32x4* xr = (const f32x4*)(KA(x) + (size_t)m * D) + lane; const f32x4* gr = (const f32x4*)KA(norm_mix) + lane;
            float s = 0.f; v2u* o8 = (v2u*)(XN + (size_t)m * D) + lane;
#pragma unroll
            for (int j = 0; j < 4; ++j) { const f32x4 v = xr[64 * j], g = gr[64 * j]; s += (v[0] * v[0] + v[1] * v[1]) + (v[2] * v[2] + v[3] * v[3]);
                v2u w; w.x = pk2(v[0] * g[0], v[1] * g[1]); w.y = pk2(v[2] * g[2], v[3] * g[3]); o8[64 * j] = w; }
            s = wave_sum(s);
            if (lane < 32) SSQ[(size_t)m * 32 + lane] = (lane == 0) ? s : 0.f;
        }
    }
    for (int e = blockIdx.x * 512 + tid; e < 2 * 4096; e += gridDim.x * 512) {
        const int li = e >> 12, gp = e & 4095, g = gp >> 6, p = gp & 63;
        unsigned char* pb = ws + WS_S5P + (size_t)li * MiB;
        const double lr = (double)KA(s5_lam_re)[li * 4096 + gp], lim = (double)KA(s5_lam_im)[li * 4096 + gp], dt = exp((double)KA(s5_log_dt)[li * 64 + g]);
        const double mag = exp(lr * dt), ang = lim * dt, abr = mag * cos(ang), abi = mag * sin(ang);
        const double den = lr * lr + lim * lim, fre = ((abr - 1.0) * lr + abi * lim) / den, fim = (abi * lr - (abr - 1.0) * lim) / den;
        const double mag64 = exp(lr * dt * 64.0), ang64 = lim * dt * 64.0;
        ((f32x2*)(pb + S5P_LAM))[gp] = (f32x2){(float)abr, (float)abi};
        ((f32x2*)(pb + S5P_L64))[gp] = (f32x2){(float)(mag64 * cos(ang64)), (float)(mag64 * sin(ang64))};
        float* BB = (float*)(pb + S5P_BB) + (size_t)gp * 32;
        const float* bre = KA(s5_b_re) + ((size_t)li * 4096 + gp) * 16; const float* bim = KA(s5_b_im) + ((size_t)li * 4096 + gp) * 16;
#pragma unroll
        for (int h = 0; h < 16; ++h) { const double br = (double)bre[h], bi = (double)bim[h]; BB[h] = (float)(fre * br - fim * bi); BB[16 + h] = (float)(fre * bi + fim * br); }
        bf16* CT = (bf16*)(pb + S5P_CT);
#pragma unroll
        for (int h = 0; h < 16; ++h) { const size_t ci = (((size_t)li * 64 + g) * 16 + h) * 64 + p;
            CT[(g * 16 + h) * 128 + p] = (bf16)f2bf(KA(s5_c_re)[ci]); CT[(g * 16 + h) * 128 + 64 + p] = (bf16)f2bf(-KA(s5_c_im)[ci]); }
    }
}

__device__ __forceinline__ void s5_stage_u(const bf16* XN, int c, int g, int lane, const LAS float* rstdL, LAS float* U) {
    const v4u* src = (const v4u*)(XN + (size_t)(64 * c + lane) * D + 16 * g);
    const v4u w0 = src[0], w1 = src[1]; const float rs = rstdL[lane];
    LAS f32x4* o = (LAS f32x4*)(U + lane * 16);
    o[0] = (f32x4){bf_lo(w0.x) * rs, bf_hi(w0.x) * rs, bf_lo(w0.y) * rs, bf_hi(w0.y) * rs};
    o[1] = (f32x4){bf_lo(w0.z) * rs, bf_hi(w0.z) * rs, bf_lo(w0.w) * rs, bf_hi(w0.w) * rs};
    o[2] = (f32x4){bf_lo(w1.x) * rs, bf_hi(w1.x) * rs, bf_lo(w1.y) * rs, bf_hi(w1.y) * rs};
    o[3] = (f32x4){bf_lo(w1.z) * rs, bf_hi(w1.z) * rs, bf_lo(w1.w) * rs, bf_hi(w1.w) * rs};
    LDS_WAIT();
}
__device__ __forceinline__ void s5_rstd_table(const float* SSQ, int c, int tid, LAS float* rstdL) {
    __syncthreads();
    if (tid < 64) { const f32x4* p = (const f32x4*)(SSQ + (size_t)(64 * c + tid) * 32); float s = 0.f;
#pragma unroll
        for (int i = 0; i < 8; ++i) { const f32x4 v = p[i]; s += (v[0] + v[1]) + (v[2] + v[3]); }
        rstdL[tid] = __builtin_amdgcn_rsqf(s * (1.0f / 1024.0f) + 1e-6f); }
    __syncthreads();
}
#define S5_STEP(t) do { const LAS f32x4* up = (const LAS f32x4*)(U + (t) * 16); const f32x4 u0 = up[0], u1 = up[1], u2 = up[2], u3 = up[3]; \
    float bre = bb[0][0] * u0[0], bim = bb[4][0] * u0[0]; \
    bre += bb[0][1] * u0[1]; bim += bb[4][1] * u0[1]; bre += bb[0][2] * u0[2]; bim += bb[4][2] * u0[2]; bre += bb[0][3] * u0[3]; bim += bb[4][3] * u0[3]; \
    _Pragma("unroll") for (int q = 0; q < 4; ++q) { bre += bb[1][q] * u1[q]; bim += bb[5][q] * u1[q]; } \
    _Pragma("unroll") for (int q = 0; q < 4; ++q) { bre += bb[2][q] * u2[q]; bim += bb[6][q] * u2[q]; } \
    _Pragma("unroll") for (int q = 0; q < 4; ++q) { bre += bb[3][q] * u3[q]; bim += bb[7][q] * u3[q]; } \
    const float nre = lam[0] * sre - lam[1] * sim + bre, nim = lam[0] * sim + lam[1] * sre + bim; sre = nre; sim = nim; } while (0)

__device__ __forceinline__ void s5_phaseA(const unsigned char* pb, const bf16* XN, const float* SSQ, f32x2* SLOC, LAS unsigned char* lds, int tid, int lane, int wave) {
    LAS float* rstdL = (LAS float*)lds; LAS float* U = (LAS float*)(lds + 1024 + wave * 4096);
    const f32x2* LAM = (const f32x2*)(pb + S5P_LAM); const f32x4* BB = (const f32x4*)(pb + S5P_BB);
    for (int c = blockIdx.x; c < NCHUNK; c += gridDim.x) {
        s5_rstd_table(SSQ, c, tid, rstdL);
        for (int gi = 0; gi < 8; ++gi) {
            const int g = wave + 8 * gi;
            s5_stage_u(XN, c, g, lane, rstdL, U);
            f32x4 bb[8];
#pragma unroll
            for (int i = 0; i < 8; ++i) bb[i] = BB[(size_t)(g * 64 + lane) * 8 + i];
            const f32x2 lam = LAM[g * 64 + lane]; float sre = 0.f, sim = 0.f;
#pragma unroll 4
            for (int t = 0; t < 64; ++t) S5_STEP(t);
            SLOC[(size_t)(c * 64 + g) * 64 + lane] = (f32x2){sre, sim};
            LDS_WAIT();
        }
    }
}
__device__ __forceinline__ void s5_phaseB(const unsigned char* pb, const f32x2* SLOC, f32x2* CAR, int tid) {
    const int gid = blockIdx.x * 512 + tid;
    if (gid < 4096) {
        const f32x2 l = ((const f32x2*)(pb + S5P_L64))[gid]; float sre = 0.f, sim = 0.f;
#pragma unroll 8
        for (int c = 0; c < NCHUNK; ++c) { CAR[(size_t)c * 4096 + gid] = (f32x2){sre, sim}; const f32x2 v = SLOC[(size_t)c * 4096 + gid];
            const float nre = l[0] * sre - l[1] * sim + v[0], nim = l[0] * sim + l[1] * sre + v[1]; sre = nre; sim = nim; }
    }
}
__device__ __forceinline__ void s5_phaseC(const unsigned char* pb, const bf16* XN, const float* SSQ, const f32x2* CAR, const float* dskip, bf16* Z, LAS unsigned char* lds, int tid, int lane, int wave) {
    LAS float* rstdL = (LAS float*)lds; LAS float* U = (LAS float*)(lds + 1024 + wave * 12800); LAS bf16* SL = (LAS bf16*)(lds + 1024 + wave * 12800 + 4096);
    const f32x2* LAM = (const f32x2*)(pb + S5P_LAM); const f32x4* BB = (const f32x4*)(pb + S5P_BB); const bf16* CT = (const bf16*)(pb + S5P_CT);
    const int col = lane & 15, quad = lane >> 4;
    for (int c = blockIdx.x; c < NCHUNK; c += gridDim.x) {
        s5_rstd_table(SSQ, c, tid, rstdL);
        for (int gi = 0; gi < 8; ++gi) {
            const int g = wave + 8 * gi;
            s5_stage_u(XN, c, g, lane, rstdL, U);
            f32x4 bb[8];
#pragma unroll
            for (int i = 0; i < 8; ++i) bb[i] = BB[(size_t)(g * 64 + lane) * 8 + i];
            const f32x2 lam = LAM[g * 64 + lane]; const f32x2 s0 = CAR[(size_t)(c * 64 + g) * 64 + lane]; float sre = s0[0], sim = s0[1];
            bf16x8 cf[4];
#pragma unroll
            for (int ks = 0; ks < 4; ++ks) cf[ks] = *(const bf16x8*)(CT + (g * 16 + col) * 128 + 32 * ks + 8 * quad);
            const float dsk = dskip[16 * g + col];
            for (int half = 0; half < 2; ++half) {
#pragma unroll 4
                for (int tt = 0; tt < 32; ++tt) { S5_STEP(32 * half + tt); SL[tt * 136 + lane] = (bf16)f2bf(sre); SL[tt * 136 + 64 + lane] = (bf16)f2bf(sim); }
                LDS_WAIT();
#pragma unroll
                for (int mt = 0; mt < 2; ++mt) {
                    f32x4 acc = (f32x4){0.f, 0.f, 0.f, 0.f};
#pragma unroll
                    for (int ks = 0; ks < 4; ++ks) { const bf16x8 av = *(const LAS bf16x8*)(SL + (16 * mt + col) * 136 + 32 * ks + 8 * quad); acc = __builtin_amdgcn_mfma_f32_16x16x32_bf16(av, cf[ks], acc, 0, 0, 0); }
#pragma unroll
                    for (int j = 0; j < 4; ++j) { const int tl = 32 * half + 16 * mt + 4 * quad + j; const float y = acc[j] + dsk * U[tl * 16 + col];
                        const float a2 = 1.5957691216057308f * (y + 0.044715f * y * y * y); const float z = y * __builtin_amdgcn_rcpf(1.0f + __builtin_amdgcn_exp2f(-1.4426950408889634f * a2));
                        Z[(size_t)(64 * c + tl) * D + 16 * g + col] = (bf16)f2bf(z); }
                }
                LDS_WAIT();
            }
        }
    }
}

__device__ __forceinline__ void gla_g1(const bf16* Kb, const bf16* Vb, const float* LA, bf16* UPD, float* DEC, LAS unsigned char* lds, int tid, int lane, int wave) {
    LAS bf16* KD = (LAS bf16*)lds; LAS bf16* VT = (LAS bf16*)(lds + 18432);
    const int col = lane & 15, quad = lane >> 4;
    for (int item = blockIdx.x; item < 1024; item += gridDim.x) {
        const int c = item >> 2, h = item & 3;
        __syncthreads();
        if (tid < 128) {
            const int dk = tid; float cum[64]; float run = 0.f;
#pragma unroll
            for (int t = 0; t < 64; ++t) { run += LA[(size_t)(64 * c + t) * 512 + 128 * h + dk]; cum[t] = run; }
            DEC[(c * 4 + h) * 128 + dk] = __expf(run);
#pragma unroll
            for (int t8 = 0; t8 < 8; ++t8) { float kd[8];
#pragma unroll
                for (int i = 0; i < 8; ++i) { const int t = 8 * t8 + i; kd[i] = bf2f(Kb[(size_t)(64 * c + t) * 512 + 128 * h + dk]) * __expf(run - cum[t]); }
                v4u w; w.x = pk2(kd[0], kd[1]); w.y = pk2(kd[2], kd[3]); w.z = pk2(kd[4], kd[5]); w.w = pk2(kd[6], kd[7]);
                *(LAS v4u*)(KD + dk * 72 + 8 * t8) = w; }
        } else if (tid < 384) {
            const int dv = tid - 128;
#pragma unroll
            for (int t8 = 0; t8 < 8; ++t8) { unsigned short e[8];
#pragma unroll
                for (int i = 0; i < 8; ++i) e[i] = Vb[(size_t)(64 * c + 8 * t8 + i) * 1024 + 256 * h + dv];
                v4u w; w.x = e[0] | ((unsigned)e[1] << 16); w.y = e[2] | ((unsigned)e[3] << 16); w.z = e[4] | ((unsigned)e[5] << 16); w.w = e[6] | ((unsigned)e[7] << 16);
                *(LAS v4u*)(VT + dv * 72 + 8 * t8) = w; }
        }
        __syncthreads();
        bf16x8 bfr[2][2];
#pragma unroll
        for (int n2 = 0; n2 < 2; ++n2)
#pragma unroll
            for (int ks = 0; ks < 2; ++ks) bfr[n2][ks] = *(const LAS bf16x8*)(VT + (16 * (2 * wave + n2) + col) * 72 + 32 * ks + 8 * quad);
        bf16* out = UPD + (size_t)(c * 4 + h) * 256 * 128;
#pragma unroll
        for (int mt = 0; mt < 8; ++mt) {
            const bf16x8 a0 = *(const LAS bf16x8*)(KD + (16 * mt + col) * 72 + 8 * quad), a1 = *(const LAS bf16x8*)(KD + (16 * mt + col) * 72 + 32 + 8 * quad);
#pragma unroll
            for (int n2 = 0; n2 < 2; ++n2) {
                f32x4 acc = (f32x4){0.f, 0.f, 0.f, 0.f};
                acc = __builtin_amdgcn_mfma_f32_16x16x32_bf16(a0, bfr[n2][0], acc, 0, 0, 0); acc = __builtin_amdgcn_mfma_f32_16x16x32_bf16(a1, bfr[n2][1], acc, 0, 0, 0);
                v2u w; w.x = pk2(acc[0], acc[1]); w.y = pk2(acc[2], acc[3]);
                *(v2u*)(out + (size_t)(16 * (2 * wave + n2) + col) * 128 + 16 * mt + 4 * quad) = w;
            }
        }
    }
}
__device__ __forceinline__ void gla_g2(bf16* UPD, const float* DEC, int tid) {
    const int e = blockIdx.x * 512 + tid;
    if (e < 131072) {
        const int dk = e & 127, h = e >> 15; float st = 0.f;
#pragma unroll 8
        for (int c = 0; c < NCHUNK; ++c) { const float d = DEC[(c * 4 + h) * 128 + dk]; bf16* p = UPD + (size_t)c * 131072 + e; st = d * st + bf2f(*p); *p = (bf16)f2bf(st); }
    }
}
__device__ __forceinline__ void gla_g3(const bf16* Qb, const bf16* ST, const bf16* SG, const float* gnorm, bf16* O2, LAS unsigned char* lds, int tid, int lane, int wave) {
    LAS float* P = (LAS float*)lds;
    const int col = lane & 15, quad = lane >> 4;
    for (int item = blockIdx.x; item < 1024; item += gridDim.x) {
        const int c = item >> 2, h = item & 3;
        const bf16* st = ST + (size_t)(c * 4 + h) * 256 * 128;
        bf16x8 af[2][4];
#pragma unroll
        for (int m2 = 0; m2 < 2; ++m2)
#pragma unroll
            for (int ks = 0; ks < 4; ++ks) af[m2][ks] = *(const bf16x8*)(st + (size_t)(16 * (2 * wave + m2) + col) * 128 + 32 * ks + 8 * quad);
        f32x4 acc[2][4];
#pragma unroll
        for (int nt = 0; nt < 4; ++nt) {
            bf16x8 bq[4];
#pragma unroll
            for (int ks = 0; ks < 4; ++ks) bq[ks] = *(const bf16x8*)(Qb + (size_t)(64 * c + 16 * nt + col) * 512 + 128 * h + 32 * ks + 8 * quad);
#pragma unroll
            for (int m2 = 0; m2 < 2; ++m2) { f32x4 r = (f32x4){0.f, 0.f, 0.f, 0.f};
#pragma unroll
                for (int ks = 0; ks < 4; ++ks) r = __builtin_amdgcn_mfma_f32_16x16x32_bf16(af[m2][ks], bq[ks], r, 0, 0, 0);
                acc[m2][nt] = r; }
        }
        __syncthreads();
#pragma unroll
        for (int nt = 0; nt < 4; ++nt) { float s = 0.f;
#pragma unroll
            for (int m2 = 0; m2 < 2; ++m2) { const f32x4 r = acc[m2][nt]; s += (r[0] * r[0] + r[1] * r[1]) + (r[2] * r[2] + r[3] * r[3]); }
            s += __shfl_xor(s, 16); s += __shfl_xor(s, 32);
            if (quad == 0) P[(16 * nt + col) * 8 + wave] = s; }
        __syncthreads();
#pragma unroll
        for (int nt = 0; nt < 4; ++nt) { const int t = 16 * nt + col; const LAS f32x4* pp = (const LAS f32x4*)(P + t * 8); const f32x4 p0 = pp[0], p1 = pp[1];
            const float tot = ((p0[0] + p0[1]) + (p0[2] + p0[3])) + ((p1[0] + p1[1]) + (p1[2] + p1[3])); const float rs = __builtin_amdgcn_rsqf(tot * (1.0f / 256.0f) + 1e-6f);
#pragma unroll
            for (int m2 = 0; m2 < 2; ++m2) { const int dv0 = 16 * (2 * wave + m2) + 4 * quad; const f32x4 ng = *(const f32x4*)(gnorm + 256 * h + dv0);
                const size_t off = (size_t)(64 * c + t) * 1024 + 256 * h + dv0; const v2u sg = *(const v2u*)(SG + off); const f32x4 r = acc[m2][nt];
                v2u w; w.x = pk2(r[0] * rs * ng[0] * bf_lo(sg.x), r[1] * rs * ng[1] * bf_hi(sg.x)); w.y = pk2(r[2] * rs * ng[2] * bf_lo(sg.y), r[3] * rs * ng[3] * bf_hi(sg.y));
                *(v2u*)(O2 + off) = w; } }
    }
}

__device__ __forceinline__ void diff_combine(const bf16* O, bf16* OC, int lane, int wave) {
    const float s1 = wave_sum(KA(diff_lq1)[lane] * KA(diff_lk1)[lane]), s2 = wave_sum(KA(diff_lq2)[lane] * KA(diff_lk2)[lane]);
    const float lamv = __expf(s1) - __expf(s2) + LAMBDA_INIT;
    const int h = lane >> 3, d0 = 16 * (lane & 7);
    f32x4 sg[4];
#pragma unroll
    for (int i = 0; i < 4; ++i) sg[i] = *(const f32x4*)(KA(diff_subln) + d0 + 4 * i);
    const int gw = blockIdx.x * NWAVES + wave, NGW = gridDim.x * NWAVES;
    for (int m = gw; m < M; m += NGW) {
        const v4u* p1 = (const v4u*)(O + (size_t)m * 2048 + 256 * h + d0); const v4u* p2 = (const v4u*)(O + (size_t)m * 2048 + 256 * h + 128 + d0);
        const v4u a0 = p1[0], a1 = p1[1], b0 = p2[0], b1 = p2[1];
        float d[16];
#define DC(i, wa, wb) d[2 * (i)] = bf_lo(wa) - lamv * bf_lo(wb); d[2 * (i) + 1] = bf_hi(wa) - lamv * bf_hi(wb);
        DC(0, a0.x, b0.x) DC(1, a0.y, b0.y) DC(2, a0.z, b0.z) DC(3, a0.w, b0.w) DC(4, a1.x, b1.x) DC(5, a1.y, b1.y) DC(6, a1.z, b1.z) DC(7, a1.w, b1.w)
#undef DC
        float s = 0.f;
#pragma unroll
        for (int i = 0; i < 16; ++i) s += d[i] * d[i];
        s += __shfl_xor(s, 1); s += __shfl_xor(s, 2); s += __shfl_xor(s, 4);
        const float r = __builtin_amdgcn_rsqf(s * (1.0f / 128.0f) + 1e-5f) * (1.0f - LAMBDA_INIT);
        v4u w0, w1;
        w0.x = pk2(d[0] * r * sg[0][0], d[1] * r * sg[0][1]); w0.y = pk2(d[2] * r * sg[0][2], d[3] * r * sg[0][3]); w0.z = pk2(d[4] * r * sg[1][0], d[5] * r * sg[1][1]); w0.w = pk2(d[6] * r * sg[1][2], d[7] * r * sg[1][3]);
        w1.x = pk2(d[8] * r * sg[2][0], d[9] * r * sg[2][1]); w1.y = pk2(d[10] * r * sg[2][2], d[11] * r * sg[2][3]); w1.z = pk2(d[12] * r * sg[3][0], d[13] * r * sg[3][1]); w1.w = pk2(d[14] * r * sg[3][2], d[15] * r * sg[3][3]);
        v4u* o = (v4u*)(OC + (size_t)m * 1024 + 128 * h + d0); o[0] = w0; o[1] = w1;
    }
}
__device__ __forceinline__ void final_norm(float* X, const float* g, int lane, int wave) {
    const int gw = blockIdx.x * NWAVES + wave, NGW = gridDim.x * NWAVES;
    for (int m = gw; m < M; m += NGW) {
        f32x4* xr = (f32x4*)(X + (size_t)m * D) + lane; const f32x4* gr = (const f32x4*)g + lane;
        f32x4 v[4]; float s = 0.f;
#pragma unroll
        for (int j = 0; j < 4; ++j) { v[j] = xr[64 * j]; s += (v[j][0] * v[j][0] + v[j][1] * v[j][1]) + (v[j][2] * v[j][2] + v[j][3] * v[j][3]); }
        const float rs = 1.0f / sqrtf(wave_sum(s) * (1.0f / D) + 1e-6f);
#pragma unroll
        for (int j = 0; j < 4; ++j) xr[64 * j] = v[j] * rs * gr[64 * j];
    }
}

__global__ void __launch_bounds__(NWAVES * 64, 2) fwd_megakernel(Args a) {
    extern __shared__ __attribute__((aligned(16))) unsigned char lds_raw[];
    cg::grid_group grid = cg::this_grid();
    LAS unsigned char* lds = (LAS unsigned char*)lds_raw;
    const int G = (int)gridDim.x, bx = (int)blockIdx.x;
#define PHASE_VARS int tid_ = threadIdx.x; asm volatile("" : "+v"(tid_)); const int tid = tid_, lane = tid & 63, wave = __builtin_amdgcn_readfirstlane(tid >> 6); (void)lane; (void)wave; \
    unsigned char* ws = KA(ws); unsigned char* sc = ws + WS_SCR; bf16* XN = (bf16*)(ws + WS_XN); float* SSQ = (float*)(ws + WS_SSQ); float* X = KA(out); (void)sc; (void)XN; (void)SSQ; (void)X;


#ifndef NO_PRO
    { PHASE_VARS prologue(lds, tid, lane, wave); }
#endif

    grid.sync();

    for (int layer = 0; layer < 4; ++layer) {
        const int kind = layer % 3;
        PHASE_VARS
        const float* xold = (layer == 0) ? KA(x) : (const float*)X;
        const float* g_ffn = KA(norm_ffn) + layer * D;
        if (kind == 0) {
            const int li = layer / 3; const unsigned char* pb = ws + WS_S5P + (size_t)li * MiB;
            bf16* Z = (bf16*)(sc + SC_Z); f32x2* SLOC = (f32x2*)(sc + SC_SLOC); f32x2* CAR = (f32x2*)(sc + SC_CAR);

#ifndef NO_S5A
            s5_phaseA(pb, XN, SSQ, SLOC, lds, tid, lane, wave);
#endif

            grid.sync();

#ifndef NO_S5B
            s5_phaseB(pb, SLOC, CAR, tid);
#endif

            grid.sync();

#ifndef NO_S5C
            s5_phaseC(pb, XN, SSQ, CAR, KA(s5_d) + li * D, Z, lds, tid, lane, wave);
#endif

            grid.sync();
            { pg8::Gemm g{Z, (const bf16*)(ws + WS_WGLU) + (size_t)li * 2048 * 1024, M, 2048, D}; pg8::StaticOrder S; S.init(M, 2048, G, bx);
              pg8::EpiGluResid E{xold, X, XN, g_ffn, SSQ};

#ifndef NO_GGLU
              pg8::gemm_phase<pg8::EpiGluResid, pg8::StaticOrder, true, true>(lds, g, S, E);
#endif
 }

            grid.sync();
        } else if (kind == 1) {
            bf16 *Qb = (bf16*)(sc + SC_GQ), *Kb = (bf16*)(sc + SC_GK), *Vb = (bf16*)(sc + SC_GV), *SGb = (bf16*)(sc + SC_GSG), *UPD = (bf16*)(sc + SC_GUPD), *O2 = (bf16*)(sc + SC_GO2);
            float *LA = (float*)(sc + SC_GLA), *DEC = (float*)(sc + SC_GDEC);
            { pg8::Gemm g{XN, (const bf16*)(ws + WS_WIN), M, 3584, D}; pg8::StaticOrder S; S.init(M, 3584, G, bx);
              pg8::EpiGlaIn E{Qb, LA, KA(gla_b_a), SSQ};

#ifndef NO_GIN
              pg8::gemm_phase<pg8::EpiGlaIn, pg8::StaticOrder, true, true>(lds, g, S, E);
#endif
 }

            grid.sync();

#ifndef NO_G1
            gla_g1(Kb, Vb, LA, UPD, DEC, lds, tid, lane, wave);
#endif

            grid.sync();

#ifndef NO_G2
            gla_g2(UPD, DEC, tid);
#endif

            grid.sync();

#ifndef NO_G3
            gla_g3(Qb, UPD, SGb, KA(gla_norm), O2, lds, tid, lane, wave);
#endif

            grid.sync();
        } else {
            bf16 *Qb = (bf16*)(sc + SC_DQ), *Kb = (bf16*)(sc + SC_DK), *Vb = (bf16*)(sc + SC_DV), *Ob = (bf16*)(sc + SC_DO), *OC = (bf16*)(sc + SC_DOC);
            { pg8::Gemm g{XN, (const bf16*)(ws + WS_WQKV), M, 3072, D}; pg8::StaticOrder S; S.init(M, 3072, G, bx);
              pg8::EpiDiffQkv E{Qb, KA(pos), SSQ};

#ifndef NO_GQKV
              pg8::gemm_phase<pg8::EpiDiffQkv, pg8::StaticOrder, true, true>(lds, g, S, E);
#endif
 }

            grid.sync();
            { const attn_body::AttnTensors AT{(const attn_body::bf16*)Qb, (const attn_body::bf16*)Kb, (const attn_body::bf16*)Vb, (attn_body::bf16*)Ob};
              const attn_body::StaticOrder S(G, bx);

#ifndef NO_ATTN
              attn_body::attn_phase<attn_body::StaticOrder>((char*)lds_raw, AT, S);
#endif
 }

            grid.sync();

#ifndef NO_COMB
            diff_combine(Ob, OC, lane, wave);
#endif

            grid.sync();
        }
        for (int st = (kind == 0 ? 1 : 0); st < 3; ++st) {
            if (st == 1) {
                pg8::Gemm g{XN, (const bf16*)(ws + WS_WGU) + (size_t)layer * 5632 * 1024, M, 5632, D}; pg8::StaticOrder S; S.init(M, 5632, G, bx);
                pg8::EpiSwiglu E{(bf16*)(sc + SC_H), SSQ};

#ifndef NO_GUP
                pg8::gemm_phase<pg8::EpiSwiglu, pg8::StaticOrder, true, true>(lds, g, S, E);
#endif

            } else {
                const bf16* A; const bf16* Bt; int K; const float* gn; const float* xo;
                if (st == 0) { A = (kind == 1) ? (const bf16*)(sc + SC_GO2) : (const bf16*)(sc + SC_DOC); Bt = (kind == 1) ? (const bf16*)(ws + WS_WOG) : (const bf16*)(ws + WS_WOD); K = D; gn = g_ffn; xo = xold; }
                else { A = (const bf16*)(sc + SC_H); Bt = (const bf16*)(ws + WS_WD) + (size_t)layer * 1024 * 2816; K = FF; gn = (layer < 3) ? KA(norm_mix) + (layer + 1) * D : nullptr; xo = X; }
                pg8::Gemm g{A, Bt, M, D, K}; pg8::StaticOrder S; S.init(M, D, G, bx);
                pg8::EpiResid E{xo, X, XN, gn, SSQ};

#ifndef NO_GRES
                pg8::gemm_phase<pg8::EpiResid, pg8::StaticOrder, true, true>(lds, g, S, E);
#endif

            }
            grid.sync();
        }
    }

#ifndef NO_FIN
    { PHASE_VARS final_norm(X, KA(norm_final), lane, wave); }
#endif

}

extern "C" void kernel_launch(void* const* d_in, const int* in_sizes, int n_in, void* d_out, int out_size, void* d_ws, size_t ws_size, hipStream_t stream) {
    static int grid = 0;
    if (grid == 0) {
        if (n_in != 28 || in_sizes[0] != M * D || out_size != M * D || ws_size < WS_END) { fprintf(stderr, "kernel_launch: unexpected shapes (n_in %d, in0 %d, out %d, ws %zu need %zu)\n", n_in, n_in > 0 ? in_sizes[0] : -1, out_size, ws_size, (size_t)WS_END); grid = -1; return; }
        int dev = 0, cus = 0, per_cu = 0;
        hipGetDevice(&dev); hipDeviceGetAttribute(&cus, hipDeviceAttributeMultiprocessorCount, dev);
        if (hipFuncSetAttribute((const void*)fwd_megakernel, hipFuncAttributeMaxDynamicSharedMemorySize, LDS_BYTES) != hipSuccess) { fprintf(stderr, "kernel_launch: hipFuncSetAttribute failed\n"); grid = -1; return; }
        hipOccupancyMaxActiveBlocksPerMultiprocessor(&per_cu, (const void*)fwd_megakernel, NWAVES * 64, LDS_BYTES);
        if (per_cu < 1) { fprintf(stderr, "kernel_launch: occupancy query says %d blocks per CU\n", per_cu); per_cu = 1; }
        (void)hipGetLastError();
        grid = cus * 1;
    }
    if (grid < 0) return;
    Args a{};
    a.x = (const float*)d_in[0]; a.pos = (const int*)d_in[1]; a.norm_mix = (const float*)d_in[2]; a.norm_ffn = (const float*)d_in[3]; a.norm_final = (const float*)d_in[4];
    a.s5_lam_re = (const float*)d_in[5]; a.s5_lam_im = (const float*)d_in[6]; a.s5_log_dt = (const float*)d_in[7]; a.s5_b_re = (const float*)d_in[8]; a.s5_b_im = (const float*)d_in[9];
    a.s5_c_re = (const float*)d_in[10]; a.s5_c_im = (const float*)d_in[11]; a.s5_d = (const float*)d_in[12]; a.s5_w_glu = (const float*)d_in[13];
    a.gla_w_in = (const float*)d_in[14]; a.gla_w_a2 = (const float*)d_in[15]; a.gla_b_a = (const float*)d_in[16]; a.gla_norm = (const float*)d_in[17]; a.gla_w_o = (const float*)d_in[18];
    a.diff_w_qkv = (const float*)d_in[19]; a.diff_lq1 = (const float*)d_in[20]; a.diff_lk1 = (const float*)d_in[21]; a.diff_lq2 = (const float*)d_in[22]; a.diff_lk2 = (const float*)d_in[23];
    a.diff_subln = (const float*)d_in[24]; a.diff_w_o = (const float*)d_in[25]; a.ffn_w_gu = (const float*)d_in[26]; a.ffn_w_d = (const float*)d_in[27];
    a.out = (float*)d_out; a.ws = (unsigned char*)d_ws;
    void* args[] = {&a};
    hipError_t e = hipLaunchCooperativeKernel((const void*)fwd_megakernel, dim3(grid), dim3(NWAVES * 64), args, LDS_BYTES, stream);
    if (e != hipSuccess) fprintf(stderr, "cooperative launch failed: %s (grid %d)\n", hipGetErrorString(e), grid);
}
```

```cpp
#include <hip/hip_runtime.h>
#include <hip/hip_cooperative_groups.h>
#include <hip/hip_bf16.h>
#include <cstdio>
#include <cstdint>
#include <cstddef>
#include <cmath>
namespace cg = cooperative_groups;
__device__ __forceinline__ int fresh_lane() { int l; asm volatile("v_mbcnt_lo_u32_b32 %0, -1, 0\n\tv_mbcnt_hi_u32_b32 %0, -1, %0" : "=v"(l)); return l; }
__device__ __forceinline__ float shx(float v, int m) {
    int l = fresh_lane(); asm volatile("" : "+v"(l));
    return __builtin_bit_cast(float, __builtin_amdgcn_ds_bpermute((l ^ m) << 2, __builtin_bit_cast(int, v)));
}
namespace pg8 {
#define PG8_LAS __attribute__((address_space(3)))
typedef unsigned short bf16_t;
typedef short bf16x8 __attribute__((ext_vector_type(8)));
typedef float f32x4 __attribute__((ext_vector_type(4)));
typedef unsigned u32x4 __attribute__((ext_vector_type(4)));
constexpr int BM = 256, BK = 64, HALF = 128, HTB = HALF * BK * 2  , STAGE_BYTES = 8 * HTB, NXCD = 8, WGM = 8;

__host__ __device__ __forceinline__ int lds_byte(int r, int c) { const int st = (r >> 4) * 2 + (c >> 5), rr = r & 15, cc = c & 31, ob = rr * 64 + cc * 2; return st * 1024 + (ob ^ (((ob >> 9) & 1) << 5)); }
__host__ __device__ __forceinline__ void stage_rc(int b, int& R, int& C) { const int st = b / 1024, sb = b % 1024, swz = sb ^ (((sb >> 9) & 1) << 5); R = (st >> 1) * 16 + swz / 64; C = (st & 1) * 32 + (swz % 64) / 2; }
__host__ __device__ __forceinline__ int perm32(int rho) { const int n = rho >> 4, i = rho & 15; return 8 * (i >> 2) + 4 * n + (i & 3); }

struct Unit { int pm, pn; };
struct Gemm { const bf16_t* A; const bf16_t* Bt; int M, N, K; };

struct StaticOrder {
    int nM, nN, nwg, G, c;
    __host__ __device__ void init(int M, int N, int G_, int c_) { nM = M / BM; nN = N / BM; nwg = nM * nN; G = G_; c = c_; }
    __host__ __device__ bool next(int i, Unit& u) const {
        const long L = (long)i * G + c; if (L >= nwg) return false;
        int wgid = (int)L; { const int q = nwg / NXCD, r = nwg % NXCD, xcd = wgid % NXCD, off = wgid / NXCD; wgid = (xcd < r ? xcd * (q + 1) : r * (q + 1) + (xcd - r) * q) + off; }
        const int nig = WGM * nN, gid = wgid / nig, fm = gid * WGM, gsz = (nM - fm) < WGM ? (nM - fm) : WGM;
        u.pm = fm + ((wgid % nig) % gsz); u.pn = (wgid % nig) / gsz; return true;
    }
    __device__ __forceinline__ void a_ready(const Unit&) const {}
    __device__ __forceinline__ void done(const Unit&) const {}
};
__device__ __forceinline__ unsigned cvt_pk_bf16(float lo, float hi) { unsigned r; asm volatile("v_cvt_pk_bf16_f32 %0, %1, %2" : "=v"(r) : "v"(lo), "v"(hi)); return r; }
typedef float f32x2 __attribute__((ext_vector_type(2)));
template <class Epi, class Sched, bool ALIGN_EPI = false, bool SP2 = false>
__device__ __forceinline__ void gemm_phase(PG8_LAS unsigned char* lds, const Gemm g, const Sched& S, const Epi& E, const int wave_s) {
    int tid_ = wave_s * 64 + fresh_lane(); asm volatile("" : "+v"(tid_));
    const int tid = tid_, wid = __builtin_amdgcn_readfirstlane(tid >> 6), lane = tid & 63, wr = wid >> 2, wc = wid & 3, fr = lane & 15, fq = lane >> 4;
    const int K = g.K, nt = K / BK;
    unsigned voffA[2], voffB[2];
#pragma unroll
    for (int i = 0; i < 2; ++i) { int R, C; stage_rc(tid * 16 + i * 8192, R, C); const int Rb = Epi::PERM ? ((R & ~31) + perm32(R & 31)) : R;
        voffA[i] = (unsigned)(R * K + C) * 2u; voffB[i] = (unsigned)(Rb * K + C) * 2u; }
    const size_t kstep = (size_t)(BK * 2);
    const size_t hstep = (size_t)HALF * K * 2;
    const size_t tstep = 2 * hstep;
    const unsigned ldsw = (unsigned)wid * 1024u;
    const int aoff = lds_byte(wr * 64 + fr, fq * 8), boff = lds_byte(wc * 32 + fr, fq * 8);
#define PG8_SA(b, h) (((b) * 2 + (h)) * HTB)
#define PG8_SB(b, h) ((4 + (b) * 2 + (h)) * HTB)
#define PG8_STAGE(bufoff, gbase, voff) do { _Pragma("unroll") for (int _i = 0; _i < 2; ++_i) \
        __builtin_amdgcn_global_load_lds((const unsigned*)((const char*)(gbase) + (voff)[_i]), (PG8_LAS unsigned*)(lds + (bufoff) + ldsw + _i * 8192), 16, 0, 0); } while (0)
#define PG8_LDA(dst, b, h) do { _Pragma("unroll") for (int m = 0; m < 4; ++m) _Pragma("unroll") for (int k = 0; k < 2; ++k) dst[m][k] = *(const PG8_LAS bf16x8*)(lds + PG8_SA(b, h) + aoff + m * 2048 + k * 1024); } while (0)
#define PG8_LDB(dst, b, h) do { _Pragma("unroll") for (int n = 0; n < 2; ++n) _Pragma("unroll") for (int k = 0; k < 2; ++k) dst[n][k] = *(const PG8_LAS bf16x8*)(lds + PG8_SB(b, h) + boff + n * 2048 + k * 1024); } while (0)
#define PG8_MMA(ai, bj, At, Bt) do { __builtin_amdgcn_s_setprio(1); _Pragma("unroll") for (int m = 0; m < 4; ++m) _Pragma("unroll") for (int n = 0; n < 2; ++n) _Pragma("unroll") for (int k = 0; k < 2; ++k) \
        acc[ai][bj][m][n] = __builtin_amdgcn_mfma_f32_16x16x32_bf16(Bt[n][k], At[m][k], acc[ai][bj][m][n], 0, 0, 0); __builtin_amdgcn_s_setprio(0); } while (0)
#define PG8_WAIT_V(n) asm volatile("s_waitcnt vmcnt(" #n ")" ::: "memory")
#define PG8_WAIT_L(n) asm volatile("s_waitcnt lgkmcnt(" #n ")" ::: "memory")
#define PG8_BAR __builtin_amdgcn_s_barrier()
#define PG8_SCHED __builtin_amdgcn_sched_barrier(0)
    Unit cur, nxt; int ui = 0;
    if (!S.next(0, cur)) return;
    f32x4 acc[2][2][4][2];
#pragma unroll
    for (int a = 0; a < 2; ++a)
#pragma unroll
        for (int b = 0; b < 2; ++b)
#pragma unroll
            for (int m = 0; m < 4; ++m)
#pragma unroll
                for (int n = 0; n < 2; ++n) acc[a][b][m][n] = (f32x4){0.f, 0.f, 0.f, 0.f};
    bf16x8 At[4][2], B0[2][2], B1[2][2];
    const char* cA = (const char*)g.A + (size_t)cur.pm * tstep; const char* cB = (const char*)g.Bt + (size_t)cur.pn * tstep;
    S.a_ready(cur);
    if constexpr (SP2) {
        PG8_STAGE(PG8_SB(0, 0), cB, voffB); PG8_STAGE(PG8_SB(0, 1), cB + hstep, voffB); PG8_STAGE(PG8_SA(0, 0), cA, voffA); PG8_STAGE(PG8_SA(0, 1), cA + hstep, voffA);
        if (wr == 1) PG8_BAR;
        PG8_WAIT_V(2); PG8_BAR;
        PG8_STAGE(PG8_SB(1, 0), cB + kstep, voffB); PG8_STAGE(PG8_SA(1, 0), cA + kstep, voffA); PG8_STAGE(PG8_SB(1, 1), cB + hstep + kstep, voffB);
        PG8_WAIT_V(6); PG8_BAR;
    } else {
        PG8_STAGE(PG8_SB(0, 0), cB, voffB); PG8_STAGE(PG8_SA(0, 0), cA, voffA); PG8_STAGE(PG8_SB(0, 1), cB + hstep, voffB); PG8_STAGE(PG8_SA(0, 1), cA + hstep, voffA);
        if (wr == 1) PG8_BAR;
        PG8_WAIT_V(4); PG8_BAR;
        PG8_STAGE(PG8_SB(1, 0), cB + kstep, voffB); PG8_STAGE(PG8_SA(1, 0), cA + kstep, voffA); PG8_STAGE(PG8_SB(1, 1), cB + hstep + kstep, voffB);
        PG8_WAIT_V(6); PG8_BAR;
    }
    for (;;) {
        const bool has_next = S.next(ui + 1, nxt);
        const char* nA = has_next ? (const char*)g.A + (size_t)nxt.pm * tstep : cA; const char* nB = has_next ? (const char*)g.Bt + (size_t)nxt.pn * tstep : cB;
        for (int t = 0; t < nt; t += 2) {
            const bool last = (t == nt - 2);
            const char* a1 = cA + (size_t)(t + 1) * kstep;
            const char* a2 = last ? nA : cA + (size_t)(t + 2) * kstep; const char* b2 = last ? nB : cB + (size_t)(t + 2) * kstep;
            const char* a3 = a2 + kstep; const char* b3 = b2 + kstep;
            if (last && has_next) S.a_ready(nxt);
            if constexpr (SP2) {
            PG8_LDB(B0, 0, 0); PG8_LDB(B1, 0, 1); PG8_SCHED; PG8_LDA(At, 0, 0); PG8_STAGE(PG8_SA(1, 1), a1 + hstep, voffA);
            PG8_WAIT_V(8); PG8_WAIT_L(0); PG8_BAR; PG8_MMA(0, 0, At, B0); PG8_MMA(0, 1, At, B1); PG8_BAR; PG8_SCHED;
            PG8_LDA(At, 0, 1); PG8_STAGE(PG8_SB(0, 0), b2, voffB); PG8_STAGE(PG8_SB(0, 1), b2 + hstep, voffB); PG8_STAGE(PG8_SA(0, 0), a2, voffA);
            PG8_WAIT_V(8); PG8_WAIT_L(0); PG8_BAR; PG8_MMA(1, 0, At, B0); PG8_MMA(1, 1, At, B1); PG8_BAR; PG8_SCHED;
            PG8_LDB(B0, 1, 0); PG8_LDB(B1, 1, 1); PG8_SCHED; PG8_LDA(At, 1, 0); PG8_STAGE(PG8_SA(0, 1), a2 + hstep, voffA);
            PG8_WAIT_V(8); PG8_WAIT_L(0); PG8_BAR; PG8_MMA(0, 0, At, B0); PG8_MMA(0, 1, At, B1); PG8_BAR; PG8_SCHED;
            PG8_LDA(At, 1, 1); PG8_STAGE(PG8_SB(1, 0), b3, voffB); PG8_STAGE(PG8_SB(1, 1), b3 + hstep, voffB); PG8_STAGE(PG8_SA(1, 0), a3, voffA);
            PG8_WAIT_V(8); PG8_WAIT_L(0); PG8_BAR; PG8_MMA(1, 0, At, B0); PG8_MMA(1, 1, At, B1); PG8_BAR; PG8_SCHED;
            } else {
            PG8_LDB(B0, 0, 0); PG8_SCHED; PG8_LDA(At, 0, 0); PG8_STAGE(PG8_SA(1, 1), a1 + hstep, voffA);
            PG8_WAIT_L(8); PG8_BAR; PG8_WAIT_L(0); PG8_MMA(0, 0, At, B0); PG8_BAR; PG8_SCHED;
            PG8_LDB(B1, 0, 1); PG8_STAGE(PG8_SB(0, 0), b2, voffB);
            PG8_BAR; PG8_WAIT_L(0); PG8_MMA(0, 1, At, B1); PG8_BAR;
            PG8_LDA(At, 0, 1); PG8_STAGE(PG8_SA(0, 0), a2, voffA);
            PG8_BAR; PG8_WAIT_L(0); PG8_MMA(1, 0, At, B0); PG8_BAR; PG8_SCHED;
            PG8_STAGE(PG8_SB(0, 1), b2 + hstep, voffB);
            PG8_WAIT_V(6); PG8_BAR; PG8_MMA(1, 1, At, B1); PG8_BAR;
            PG8_LDB(B0, 1, 0); PG8_SCHED; PG8_LDA(At, 1, 0); PG8_STAGE(PG8_SA(0, 1), a2 + hstep, voffA);
            PG8_WAIT_L(8); PG8_BAR; PG8_WAIT_L(0); PG8_MMA(0, 0, At, B0); PG8_BAR; PG8_SCHED;
            PG8_LDB(B1, 1, 1); PG8_STAGE(PG8_SB(1, 0), b3, voffB);
            PG8_BAR; PG8_WAIT_L(0); PG8_MMA(0, 1, At, B1); PG8_BAR;
            PG8_LDA(At, 1, 1); PG8_STAGE(PG8_SA(1, 0), a3, voffA);
            PG8_BAR; PG8_WAIT_L(0); PG8_MMA(1, 0, At, B0); PG8_BAR; PG8_SCHED;
            PG8_STAGE(PG8_SB(1, 1), b3 + hstep, voffB);
            PG8_WAIT_V(6); PG8_BAR; PG8_MMA(1, 1, At, B1); PG8_BAR;
            }
        }
        if constexpr (ALIGN_EPI) { if (wr == 0) PG8_BAR; }
        if constexpr (!Epi::AFTER_DRAIN) { E(acc, cur, wr, wc, fr, fq, ui); S.done(cur); }
        if (!has_next) break;
#pragma unroll
        for (int a = 0; a < 2; ++a)
#pragma unroll
            for (int b = 0; b < 2; ++b)
#pragma unroll
                for (int m = 0; m < 4; ++m)
#pragma unroll
                    for (int n = 0; n < 2; ++n) acc[a][b][m][n] = (f32x4){0.f, 0.f, 0.f, 0.f};
        cur = nxt; cA = nA; cB = nB; ++ui;
        if constexpr (ALIGN_EPI) { if (wr == 1) PG8_BAR; }
    }
    PG8_WAIT_V(0);
    if constexpr (!ALIGN_EPI) { if (wr == 0) PG8_BAR; }
    PG8_BAR;
    if constexpr (Epi::AFTER_DRAIN) { E.fused(acc, cur, wr, wc, fr, fq, lds, wid, lane); S.done(cur); }
#undef PG8_SA
#undef PG8_SB
#undef PG8_STAGE
#undef PG8_LDA
#undef PG8_LDB
#undef PG8_MMA
#undef PG8_WAIT_V
#undef PG8_WAIT_L
#undef PG8_BAR
#undef PG8_SCHED
}
}
namespace pg8 {
__device__ __forceinline__ float fast_sigmoid(float x) { return __builtin_amdgcn_rcpf(1.0f + __builtin_amdgcn_exp2f(-1.4426950408889634f * x)); }
__device__ __forceinline__ float row_rstd(const float* ssq, int row, int fq) {
    const f32x4* p = (const f32x4*)(ssq + (size_t)row * 32 + 8 * fq);
    const f32x4 a = p[0], b = p[1];
    float s = ((a[0] + a[1]) + (a[2] + a[3])) + ((b[0] + b[1]) + (b[2] + b[3]));
    s += shx(s, 16); s += shx(s, 32);
    return __builtin_amdgcn_rsqf(s * (1.0f / 1024.0f) + 1e-6f);
}
__device__ __forceinline__ u32x4 pack8(const f32x4 a, const f32x4 b) { u32x4 w; w.x = cvt_pk_bf16(a[0], a[1]); w.y = cvt_pk_bf16(a[2], a[3]); w.z = cvt_pk_bf16(b[0], b[1]); w.w = cvt_pk_bf16(b[2], b[3]); return w; }

__device__ __forceinline__ float bflo(unsigned w) { return __builtin_bit_cast(float, w << 16); }
__device__ __forceinline__ float bfhi(unsigned w) { return __builtin_bit_cast(float, w & 0xffff0000u); }
struct EpiResid {
    static constexpr bool PERM = true, AFTER_DRAIN = false;
    bf16_t* xb; float* ssq;
    __device__ __forceinline__ void operator()(const f32x4 (&acc)[2][2][4][2], const Unit& u, int wr, int wc, int fr, int fq, int ui) const {
        const int col0 = u.pn * BM + wc * 32 + 8 * fq;
#pragma unroll
        for (int ai = 0; ai < 2; ++ai)
#pragma unroll
            for (int m = 0; m < 4; ++m) {
                const int row = u.pm * BM + ai * HALF + wr * 64 + m * 16 + fr;
#pragma unroll
                for (int bj = 0; bj < 2; ++bj) {
                    const size_t off = (size_t)row * 1024 + col0 + bj * HALF;
                    const u32x4 xw = *(const u32x4*)(xb + off);
                    const f32x4 x0 = (f32x4){bflo(xw.x), bfhi(xw.x), bflo(xw.y), bfhi(xw.y)} + acc[ai][bj][m][0], x1 = (f32x4){bflo(xw.z), bfhi(xw.z), bflo(xw.w), bfhi(xw.w)} + acc[ai][bj][m][1];
                    float s = ((x0[0] * x0[0] + x0[1] * x0[1]) + (x0[2] * x0[2] + x0[3] * x0[3])) + ((x1[0] * x1[0] + x1[1] * x1[1]) + (x1[2] * x1[2] + x1[3] * x1[3]));
                    s += shx(s, 16); s += shx(s, 32);
                    if (fq == 0) ssq[(size_t)row * 32 + u.pn * 8 + bj * 4 + wc] = s;
                    *(u32x4*)(xb + off) = pack8(x0, x1);
                }
                if (m == 3) asm volatile("" ::: "memory");
            }
    }
};
struct EpiGluResid {
    static constexpr bool PERM = true, AFTER_DRAIN = false;
    const float* xin; bf16_t* xb; float* ssq;
    __device__ __forceinline__ void operator()(const f32x4 (&acc)[2][2][4][2], const Unit& u, int wr, int wc, int fr, int fq, int ui) const {
        const int col0 = u.pn * HALF + wc * 32 + 8 * fq;
#pragma unroll
        for (int ai = 0; ai < 2; ++ai)
#pragma unroll
            for (int m = 0; m < 4; ++m) {
                const int row = u.pm * BM + ai * HALF + wr * 64 + m * 16 + fr;
                const size_t off = (size_t)row * 1024 + col0;
                f32x4 x0, x1;
                if (xin) { x0 = *(const f32x4*)(xin + off); x1 = *(const f32x4*)(xin + off + 4); }
                else { const u32x4 xw = *(const u32x4*)(xb + off); x0 = (f32x4){bflo(xw.x), bfhi(xw.x), bflo(xw.y), bfhi(xw.y)}; x1 = (f32x4){bflo(xw.z), bfhi(xw.z), bflo(xw.w), bfhi(xw.w)}; }
#pragma unroll
                for (int j = 0; j < 4; ++j) { x0[j] += acc[ai][0][m][0][j] * fast_sigmoid(acc[ai][1][m][0][j]); x1[j] += acc[ai][0][m][1][j] * fast_sigmoid(acc[ai][1][m][1][j]); }
                float s = ((x0[0] * x0[0] + x0[1] * x0[1]) + (x0[2] * x0[2] + x0[3] * x0[3])) + ((x1[0] * x1[0] + x1[1] * x1[1]) + (x1[2] * x1[2] + x1[3] * x1[3]));
                s += shx(s, 16); s += shx(s, 32);
                if (fq == 0) ssq[(size_t)row * 32 + u.pn * 4 + wc] = s;
                *(u32x4*)(xb + off) = pack8(x0, x1);
                if (m == 3) asm volatile("" ::: "memory");
            }
    }
};
struct EpiSwiglu {
    static constexpr bool PERM = true, AFTER_DRAIN = false;
    bf16_t* H; const PG8_LAS float* rtab;
    __device__ __forceinline__ void operator()(const f32x4 (&acc)[2][2][4][2], const Unit& u, int wr, int wc, int fr, int fq, int ui) const {
        const int col0 = u.pn * HALF + wc * 32 + 8 * fq;
#pragma unroll
        for (int ai = 0; ai < 2; ++ai)
#pragma unroll
            for (int m = 0; m < 4; ++m) {
                const int row = u.pm * BM + ai * HALF + wr * 64 + m * 16 + fr;
                const float rs = rtab[ui * 256 + ai * HALF + wr * 64 + m * 16 + fr];
                f32x4 h0, h1;
#pragma unroll
                for (int j = 0; j < 4; ++j) { const float ga = acc[ai][0][m][0][j] * rs, gb = acc[ai][0][m][1][j] * rs;
                    h0[j] = ga * fast_sigmoid(ga) * (acc[ai][1][m][0][j] * rs); h1[j] = gb * fast_sigmoid(gb) * (acc[ai][1][m][1][j] * rs); }
                *(u32x4*)(H + (size_t)row * 2816 + col0) = pack8(h0, h1);
            }
    }
};
struct EpiGlaIn {
    static constexpr bool PERM = true, AFTER_DRAIN = false;
    bf16_t* Q; float* LA; const float* ba; const PG8_LAS float* rtab;
    __device__ __forceinline__ void operator()(const f32x4 (&acc)[2][2][4][2], const Unit& u, int wr, int wc, int fr, int fq, int ui) const {
        const int pn = u.pn; const int cw = wc * 32 + 8 * fq;
        const size_t eoff = (pn < 2) ? (size_t)0 : ((pn < 4) ? (size_t)8388608 : ((pn < 8) ? (size_t)16777216 : (size_t)33554432));
        const int ld = (pn < 4) ? 512 : 1024; const int c0 = ((pn < 4) ? (pn & 1) : (pn & 3)) * 256; const float sc = (pn < 2) ? 0.08838834764831845f : 1.0f;
        bf16_t* base = Q + eoff;
#pragma unroll
        for (int ai = 0; ai < 2; ++ai)
#pragma unroll
            for (int m = 0; m < 4; ++m) {
                const int row = u.pm * BM + ai * HALF + wr * 64 + m * 16 + fr;
                const float rs = rtab[ui * 256 + ai * HALF + wr * 64 + m * 16 + fr] * sc;
#pragma unroll
                for (int bj = 0; bj < 2; ++bj) {
                    f32x4 v0 = acc[ai][bj][m][0] * rs, v1 = acc[ai][bj][m][1] * rs;
                    if (pn >= 12) {
                        const int c = (pn - 12) * 256 + bj * HALF + cw;
                        const f32x4 b0 = *(const f32x4*)(ba + c), b1 = *(const f32x4*)(ba + c + 4);
#pragma unroll
                        for (int j = 0; j < 4; ++j) { const float z0 = v0[j] + b0[j], z1 = v1[j] + b1[j];
                            v0[j] = (fminf(z0, 0.f) - __logf(1.0f + __expf(-fabsf(z0)))) * 0.0625f; v1[j] = (fminf(z1, 0.f) - __logf(1.0f + __expf(-fabsf(z1)))) * 0.0625f; }
                        float* o = LA + (size_t)row * 512 + c; *(f32x4*)o = v0; *(f32x4*)(o + 4) = v1;
                    } else {
                        if (pn >= 8) {
#pragma unroll
                            for (int j = 0; j < 4; ++j) { v0[j] = v0[j] * fast_sigmoid(v0[j]); v1[j] = v1[j] * fast_sigmoid(v1[j]); } }
                        *(u32x4*)(base + (size_t)row * ld + c0 + bj * HALF + cw) = pack8(v0, v1);
                    }
                }
            }
    }
};
struct EpiDiffQkv {
    static constexpr bool PERM = true, AFTER_DRAIN = false;
    bf16_t* Q; const int* pos; const PG8_LAS float* rtab;
    __device__ __forceinline__ void operator()(const f32x4 (&acc)[2][2][4][2], const Unit& u, int wr, int wc, int fr, int fq, int ui) const {
        const int pn = u.pn; const int cw = wc * 32 + 8 * fq;
        bf16_t* base = Q + (size_t)(pn >> 2) * 16777216; const int c0 = (pn & 3) * 256;
        const float sc = pn < 4 ? 0.18033688011112042f : 1.0f;
        const bool rope = (pn < 8) && ((wc & 1) == 0);
        int prow[2][4];
        if (rope) {
#pragma unroll
            for (int ai = 0; ai < 2; ++ai)
#pragma unroll
                for (int m = 0; m < 4; ++m) prow[ai][m] = pos[u.pm * BM + ai * HALF + wr * 64 + m * 16 + fr]; }
        const double IF[8] = {0.15915494309189535, 0.03086376340470123, 0.005985185712713705, 0.001160663641240061, 0.00022507907903927653, 4.364795279280289e-05, 8.464330808241401e-06, 1.6414262627950345e-06};
#pragma unroll
        for (int ai = 0; ai < 2; ++ai)
#pragma unroll
            for (int m = 0; m < 4; ++m) {
                const int row = u.pm * BM + ai * HALF + wr * 64 + m * 16 + fr;
                const float rs = rtab[ui * 256 + ai * HALF + wr * 64 + m * 16 + fr] * sc;
                float cs[8], sn[8];
                if (rope) { const double p = (double)prow[ai][m];
#pragma unroll
                    for (int i = 0; i < 8; ++i) { const double r = p * IF[i]; const float f = (float)(r - __builtin_floor(r)); cs[i] = __builtin_amdgcn_cosf(f); sn[i] = __builtin_amdgcn_sinf(f); } }
#pragma unroll
                for (int bj = 0; bj < 2; ++bj) {
                    f32x4 v0 = acc[ai][bj][m][0] * rs, v1 = acc[ai][bj][m][1] * rs;
                    if (rope) {
#pragma unroll
                        for (int j = 0; j < 4; ++j) {
                            const float o0 = shx(v0[j], 16), o1 = shx(v1[j], 16);
                            if (fq == 0) { v0[j] = v0[j] * cs[j] - o0 * sn[j]; v1[j] = v1[j] * cs[4 + j] - o1 * sn[4 + j]; }
                            else if (fq == 1) { v0[j] = v0[j] * cs[j] + o0 * sn[j]; v1[j] = v1[j] * cs[4 + j] + o1 * sn[4 + j]; }
                        }
                    }
                    *(u32x4*)(base + (size_t)row * 1024 + c0 + bj * HALF + cw) = pack8(v0, v1);
                }
            }
    }
};
}
namespace attn_body {
using bf16=__hip_bfloat16;
using bf16x8=__attribute__((ext_vector_type(8)))short;
using s16x4=__attribute__((ext_vector_type(4)))short;
using f32x16=__attribute__((ext_vector_type(16)))float;
using u32x4=__attribute__((ext_vector_type(4)))unsigned;
constexpr int BATCH=1,NHEAD=16,SEQ=16384,D=64,DM=NHEAD*D;
constexpr int NW=8,QBLK=32,QB=QBLK*NW,KVBLK=64,NQB=SEQ/QB;
constexpr int ATTN_PITCH=DM, ATTN_UNIT_ROWS=QB;
__device__ __forceinline__ int crow(int r,int hi){return (r&3)+8*(r>>2)+4*hi;}
#define SBAR() __builtin_amdgcn_sched_barrier(0)
__device__ __forceinline__ void cmask(f32x16&p0,f32x16&p1,int jb,int qrel,int hi){
  const float NEG=-INFINITY; (void)hi;
  if(jb>(qrel>>6)){
  #pragma unroll
  for(int r=0;r<16;++r){p0[r]=NEG;p1[r]=NEG;}}
}

constexpr int NSLOT=3, SLOTB=8192;
constexpr int LDS_K=0, LDS_V=NSLOT*SLOTB, LDS_WS=3*NSLOT*SLOTB, LDS_OST=LDS_WS+NW*64*4, LDS_BYTES=LDS_OST+NW*4096;
constexpr float C2=0.125f*1.4426950408889634f;
__device__ __forceinline__ void glds16(const void*gsrc,unsigned lds_dst){unsigned keep;
  asm volatile("s_mov_b32 %0, m0\n\ts_mov_b32 m0, %2\n\ts_nop 0\n\tglobal_load_lds_dwordx4 %1, off\n\ts_mov_b32 m0, %0":"=&s"(keep):"v"(gsrc),"s"(lds_dst):"memory");}
__device__ __forceinline__ float max3f(float a,float b,float c){float r;asm("v_max3_f32 %0, %1, %2, %3":"=v"(r):"v"(a),"v"(b),"v"(c));return r;}
__device__ __forceinline__ float max2f(float a,float b){float r;asm("v_max_f32_e32 %0, %1, %2":"=v"(r):"v"(a),"v"(b));return r;}
__device__ __forceinline__ float fadd_s(float a,float b){float r;asm("v_add_f32_e32 %0, %1, %2":"=v"(r):"v"(a),"v"(b));return r;}
__device__ __forceinline__ float fsub_s(float a,float b){float r;asm("v_sub_f32_e32 %0, %1, %2":"=v"(r):"v"(a),"v"(b));return r;}
typedef float f32x2_t __attribute__((ext_vector_type(2))); typedef __bf16 bf16x2_t __attribute__((ext_vector_type(2)));
__device__ __forceinline__ unsigned cvtpk_s(float lo,float hi){f32x2_t v={lo,hi};bf16x2_t b=__builtin_convertvector(v,bf16x2_t);return __builtin_bit_cast(unsigned,b);}
#define WAIT_BAR(N) asm volatile("s_waitcnt vmcnt(" #N ") lgkmcnt(0)\n\ts_barrier":::"memory")

__device__ __forceinline__ void qkt(f32x16&p0,f32x16&p1,const char*Kslot,const bf16x8*qr,const f32x16&negm,int r32,int hi){
  const char*kb=Kslot+hi*1024+r32*16;
  #pragma unroll
  for(int d0=0;d0<4;++d0){
    const bf16x8 b0=*reinterpret_cast<const bf16x8*>(kb+d0*2048);
    const bf16x8 b1=*reinterpret_cast<const bf16x8*>(kb+d0*2048+512);
    if(d0==0){p0=__builtin_amdgcn_mfma_f32_32x32x16_bf16(b0,qr[0],negm,0,0,0);p1=__builtin_amdgcn_mfma_f32_32x32x16_bf16(b1,qr[0],negm,0,0,0);}
    else{p0=__builtin_amdgcn_mfma_f32_32x32x16_bf16(b0,qr[d0],p0,0,0,0);p1=__builtin_amdgcn_mfma_f32_32x32x16_bf16(b1,qr[d0],p1,0,0,0);}}
}
typedef __attribute__((address_space(3))) const char* lds_cptr;
typedef short v4i16_t __attribute__((ext_vector_type(4)));
__device__ __forceinline__ void kload8(bf16x8*kf,lds_cptr kp){
  kf[0]=*(const __attribute__((address_space(3))) bf16x8*)(kp);      kf[1]=*(const __attribute__((address_space(3))) bf16x8*)(kp+512);
  kf[2]=*(const __attribute__((address_space(3))) bf16x8*)(kp+2048); kf[3]=*(const __attribute__((address_space(3))) bf16x8*)(kp+2560);
  kf[4]=*(const __attribute__((address_space(3))) bf16x8*)(kp+4096); kf[5]=*(const __attribute__((address_space(3))) bf16x8*)(kp+4608);
  kf[6]=*(const __attribute__((address_space(3))) bf16x8*)(kp+6144); kf[7]=*(const __attribute__((address_space(3))) bf16x8*)(kp+6656);
}
__device__ __forceinline__ void kload2(bf16x8*kf,lds_cptr kp,int j){ kf[2*j]=*(const __attribute__((address_space(3))) bf16x8*)(kp+j*2048); kf[2*j+1]=*(const __attribute__((address_space(3))) bf16x8*)(kp+j*2048+512); }
__device__ __forceinline__ s16x4 vtr(lds_cptr p){ return __builtin_bit_cast(s16x4,__builtin_amdgcn_ds_read_tr16_b64_v4i16((__attribute__((address_space(3))) v4i16_t*)p)); }
__device__ __forceinline__ float rowmax(const f32x16&p0,const f32x16&p1){
  float a=max3f(p0[0],p0[1],p1[0]),b=max3f(p0[2],p0[3],p1[1]);a=max3f(a,p1[2],p1[3]);
  #pragma unroll
  for(int r=4;r<16;r+=4){a=max3f(a,p0[r],p0[r+1]);b=max3f(b,p0[r+2],p0[r+3]);a=max3f(a,p1[r],p1[r+1]);b=max3f(b,p1[r+2],p1[r+3]);}
  const float m=max2f(a,b);
  auto rr=__builtin_amdgcn_permlane32_swap(__float_as_uint(m),__float_as_uint(m),false,false);
  return max2f(__uint_as_float(rr[0]),__uint_as_float(rr[1]));
}
__device__ __forceinline__ void pv(f32x16*o,int vb,bf16x8 pa0,bf16x8 pa1,bf16x8 pa2,bf16x8 pa3){
  #pragma unroll
  for(int d0=0;d0<2;++d0){s16x4 lo[4],hi[4];
    #pragma unroll
    for(int ks=0;ks<4;++ks){
      asm volatile("ds_read_b64_tr_b16 %0,%1 offset:%c2":"=&v"(lo[ks]):"v"(vb),"i"(d0*4096+ks*1024):"memory");
      asm volatile("ds_read_b64_tr_b16 %0,%1 offset:%c2":"=&v"(hi[ks]):"v"(vb),"i"(d0*4096+ks*1024+512):"memory");}
    asm volatile("s_waitcnt lgkmcnt(0)":::"memory");SBAR();
    #define PK(k) (bf16x8){lo[k][0],lo[k][1],lo[k][2],lo[k][3],hi[k][0],hi[k][1],hi[k][2],hi[k][3]}
    o[d0]=__builtin_amdgcn_mfma_f32_32x32x16_bf16(pa0,PK(0),o[d0],0,0,0);
    o[d0]=__builtin_amdgcn_mfma_f32_32x32x16_bf16(pa1,PK(1),o[d0],0,0,0);
    o[d0]=__builtin_amdgcn_mfma_f32_32x32x16_bf16(pa2,PK(2),o[d0],0,0,0);
    o[d0]=__builtin_amdgcn_mfma_f32_32x32x16_bf16(pa3,PK(3),o[d0],0,0,0);
    #undef PK
  }
}

#ifndef ATTN_STORE16
#define ATTN_STORE16(p,v) (*(u32x4*)(p)=(v))
#endif
template<int THRL> __device__ __forceinline__ void attn_unit(int qb,const bf16*Qh,const bf16*__restrict__ Kh,const bf16*__restrict__ Vh,bf16*Oh,int opitch,char*shm,const int wave_s){
  int tid_=wave_s*64+fresh_lane(); asm volatile("":"+v"(tid_)); const int tid=tid_,lane=tid&63,r32=lane&31,hi=lane>>5; const int wid=__builtin_amdgcn_readfirstlane(tid>>6);
  const int q0=qb*QB;
  const bf16*Qw=Qh+(long)(q0+wid*QBLK)*DM;
  const unsigned lds0=(unsigned)(uintptr_t)shm;
  float*wsf=(float*)(shm+LDS_WS)+wid*64;
  const bf16*ksrc=Kh+(long)lane*DM+wid*8;
  const bf16*vsrc=Vh+(long)(16*(wid&3)+(lane>>2))*DM+(wid>>2)*32+(lane&3)*8;
  const unsigned kdst=lds0+LDS_K+wid*1024, vdst=lds0+LDS_V+wid*1024;
  #define DMA_K(t,slot) glds16(ksrc+(long)(t)*KVBLK*DM,(unsigned)__builtin_amdgcn_readfirstlane(kdst+(slot)))
  #define DMA_V(t,slot) do{ glds16(vsrc+(long)(t)*KVBLK*DM,(unsigned)__builtin_amdgcn_readfirstlane(vdst+2*(slot))); glds16(vsrc+(long)(t)*KVBLK*DM+64,(unsigned)__builtin_amdgcn_readfirstlane(vdst+2*(slot)+8192)); }while(0)
  const int vb0=(int)(lds0+LDS_V)+((lane>>4)&1)*32+(lane&3)*8+(4*hi+((lane&15)>>2))*64;
  const char*Kbase=shm+LDS_K; bf16x8 kf[8];
  const lds_cptr shm3=(lds_cptr)shm; const lds_cptr kp0=shm3+LDS_K+hi*1024+r32*16; const lds_cptr vp0=shm3+LDS_V+((lane>>4)&1)*32+(lane&3)*8+(4*hi+((lane&15)>>2))*64;
  const int NT=(q0+QB)/KVBLK;
  DMA_K(0,0);DMA_V(0,0);DMA_K(1,SLOTB);
  bf16x8 qr[4];
  #pragma unroll
  for(int d0=0;d0<4;++d0)qr[d0]=*reinterpret_cast<const bf16x8*>(&Qw[(long)r32*DM+d0*16+hi*8]);
  float mhat=0.f,l_reg=0.f;f32x16 o[2];o[0]=f32x16{};o[1]=f32x16{};f32x16 o2[2];o2[0]=f32x16{};o2[1]=f32x16{};const f32x16 ZC=f32x16{};
  const int qrel=wid*QBLK+r32;
  #define CMASK(P0,P1,t) do{int jb_=(t)-(NT-4); if(jb_>=0)cmask(P0,P1,jb_,qrel,hi);}while(0)
  bool resc=false;
  #define START(P0,P1) do{ const float rm=rowmax(P0,P1); resc=false; \
    { const float dl=rm; mhat=fadd_s(mhat,dl); \
      _Pragma("unroll") for(int r=0;r<16;++r){P0[r]=fsub_s(P0[r],dl);P1[r]=fsub_s(P1[r],dl);} \
      } \
    _Pragma("unroll") for(int r=0;r<16;++r)P0[r]=__builtin_amdgcn_exp2f(P0[r]); }while(0)
  #define RESC() do{ if(resc){ asm volatile("s_waitcnt lgkmcnt(0)":::"memory"); \
      _Pragma("unroll") for(int d_=0;d_<2;++d_) _Pragma("unroll") for(int r=0;r<16;++r){const float f_=wsf[crow(r,hi)];o[d_][r]*=f_;o2[d_][r]*=f_;} } }while(0)
  f32x16 pA0,pA1,pB0,pB1;
  int sl_prev=0,sl_cur=0,sl_next=SLOTB;
  #define ROT() do{sl_prev=sl_cur;sl_cur=sl_next;sl_next=(sl_next==(NSLOT-1)*SLOTB)?0:sl_next+SLOTB;}while(0)
  DMA_K(2,2*SLOTB);
  WAIT_BAR(3);
  qkt(pA0,pA1,Kbase,qr,ZC,r32,hi);asm volatile("s_nop 15\n\ts_nop 7":"+v"(pA0),"+v"(pA1));CMASK(pA0,pA1,0);
  START(pA0,pA1);
  _Pragma("unroll") for(int r=0;r<16;++r)pA1[r]=__builtin_amdgcn_exp2f(pA1[r]);
  WAIT_BAR(0);
  DMA_K(3,0);DMA_V(1,SLOTB);
  ROT();
  kload8(kf,kp0+sl_cur);
  WAIT_BAR(3);
  s16x4 vlo[8],vhi[8]; u32x4 pw0,pw1,pw2,pw3;
  #define PKW(P,B) cvtpk_s(P[B],P[B+1])
  #define PAF(k) __builtin_bit_cast(bf16x8,pw##k)
  #define VFR(i) (bf16x8){vlo[i][0],vlo[i][1],vlo[i][2],vlo[i][3],vhi[i][0],vhi[i][1],vhi[i][2],vhi[i][3]}
  #define PIN(x) asm volatile("":"+v"(x))
  #define MX3(a,b,c) __builtin_fmaxf(__builtin_fmaxf((a),(b)),(c))
  #define GAPA(MF,A0,A1,A2,A3,W0,W1,PW) do{ MF; sacc+=A0; sacc+=A1; sacc+=A2; sacc+=A3; PIN(sacc); W0; W1; PIN(PW); SBAR(); }while(0)
  #define EX(v) __builtin_amdgcn_exp2f(v)
  #define GAPB(MF,X,B) do{ MF; X[B]=EX(X[B]-mhat); X[B+1]=EX(X[B+1]-mhat); X[B+2]=EX(X[B+2]-mhat); X[B+3]=EX(X[B+3]-mhat); PIN(X); SBAR(); }while(0)
  #define VRD(i) do{ vlo[i]=vtr(vp_+(((i)>>2)*4096+((i)&3)*1024)); vhi[i]=vtr(vp_+(((i)>>2)*4096+((i)&3)*1024+512)); }while(0)
  #define KRD(G,j) do{ if(G){ kload2(kf,kp0+sl_next,j); SBAR(); } }while(0)
  #define STEP(C0,C1,P0,P1,t,GK,GV,GL) do{ SBAR(); \
    const lds_cptr vp_=vp0+2*sl_prev; \
    VRD(0); SBAR(); float sacc=(P0[0]+P0[1]); \
    GAPA(C0=__builtin_amdgcn_mfma_f32_32x32x16_bf16(kf[0],qr[0],ZC,0,0,0), P0[2],P0[3],P0[4],P0[5],     pw0[0]=PKW(P0,0), pw0[1]=PKW(P0,2), pw0); \
    VRD(4); SBAR(); GAPA(C1=__builtin_amdgcn_mfma_f32_32x32x16_bf16(kf[1],qr[0],ZC,0,0,0), P0[6],P0[7],P0[8],P0[9],     pw0[2]=PKW(P0,4), pw0[3]=PKW(P0,6), pw0); \
    VRD(1); SBAR(); GAPA(C0=__builtin_amdgcn_mfma_f32_32x32x16_bf16(kf[2],qr[1],C0,0,0,0),   P0[10],P0[11],P0[12],P0[13], pw1[0]=PKW(P0,8), pw1[1]=PKW(P0,10), pw1); \
    VRD(5); SBAR(); GAPA(C1=__builtin_amdgcn_mfma_f32_32x32x16_bf16(kf[3],qr[1],C1,0,0,0),   P0[14],P0[15],P1[0],P1[1],   pw1[2]=PKW(P0,12),pw1[3]=PKW(P0,14), pw1); \
    VRD(2); SBAR(); GAPA(C0=__builtin_amdgcn_mfma_f32_32x32x16_bf16(kf[4],qr[2],C0,0,0,0),   P1[2],P1[3],P1[4],P1[5],     pw2[0]=PKW(P1,0), pw2[1]=PKW(P1,2), pw2); \
    VRD(6); SBAR(); GAPA(C1=__builtin_amdgcn_mfma_f32_32x32x16_bf16(kf[5],qr[2],C1,0,0,0),   P1[6],P1[7],P1[8],P1[9],     pw2[2]=PKW(P1,4), pw2[3]=PKW(P1,6), pw2); \
    VRD(3); SBAR(); GAPA(C0=__builtin_amdgcn_mfma_f32_32x32x16_bf16(kf[6],qr[3],C0,0,0,0),   P1[10],P1[11],P1[12],P1[13], pw3[0]=PKW(P1,8), pw3[1]=PKW(P1,10), pw3); \
    VRD(7); SBAR(); GAPA(C1=__builtin_amdgcn_mfma_f32_32x32x16_bf16(kf[7],qr[3],C1,0,0,0),   P1[14],P1[15],0.f,0.f,       pw3[2]=PKW(P1,12),pw3[3]=PKW(P1,14), pw3); \
    l_reg+=sacc; \
    if(GK){DMA_K((t)+3,sl_cur);} if(GV){DMA_V((t)+1,sl_next);} \
    CMASK(C0,C1,t); \
    { float a=MX3(C0[0],C0[1],C1[0]),b=MX3(C0[2],C0[3],C1[1]); a=MX3(a,C1[2],C1[3]); \
      _Pragma("unroll") for(int r=4;r<16;r+=4){a=MX3(a,C0[r],C0[r+1]);b=MX3(b,C0[r+2],C0[r+3]);a=MX3(a,C1[r],C1[r+1]);b=MX3(b,C1[r+2],C1[r+3]);} \
      float rm=__builtin_fmaxf(a,b); { auto rr=__builtin_amdgcn_permlane32_swap(__float_as_uint(rm),__float_as_uint(rm),false,false); rm=__builtin_fmaxf(__uint_as_float(rr[0]),__uint_as_float(rr[1])); } \
      resc=false; rm-=mhat; \
      if(__builtin_expect(__any(rm>(float)THRL),0)){ const float dl=__builtin_fmaxf(rm,0.f); mhat+=dl; \
        const float f=__builtin_amdgcn_exp2f(-dl); l_reg*=f; if(hi==0)wsf[r32]=f; resc=true; } } \
    SBAR(); \
    GAPB(o[0]=__builtin_amdgcn_mfma_f32_32x32x16_bf16(PAF(0),VFR(0),o[0],0,0,0), C0,0); \
    GAPB(o[1]=__builtin_amdgcn_mfma_f32_32x32x16_bf16(PAF(0),VFR(4),o[1],0,0,0), C0,4); \
    KRD(GL,0); GAPB(o[0]=__builtin_amdgcn_mfma_f32_32x32x16_bf16(PAF(1),VFR(1),o[0],0,0,0), C0,8); \
    KRD(GL,1); GAPB(o[1]=__builtin_amdgcn_mfma_f32_32x32x16_bf16(PAF(1),VFR(5),o[1],0,0,0), C0,12); \
    KRD(GL,2); GAPB(o[0]=__builtin_amdgcn_mfma_f32_32x32x16_bf16(PAF(2),VFR(2),o[0],0,0,0), C1,0); \
    KRD(GL,3); GAPB(o[1]=__builtin_amdgcn_mfma_f32_32x32x16_bf16(PAF(2),VFR(6),o[1],0,0,0), C1,4); \
    GAPB(o[0]=__builtin_amdgcn_mfma_f32_32x32x16_bf16(PAF(3),VFR(3),o[0],0,0,0), C1,8); \
    GAPB(o[1]=__builtin_amdgcn_mfma_f32_32x32x16_bf16(PAF(3),VFR(7),o[1],0,0,0), C1,12); \
    }while(0)
  #define PV2() do{ SBAR(); pv(o2,vb0+2*sl_prev+8192,PAF(0),PAF(1),PAF(2),PAF(3)); SBAR(); }while(0)
  int t=1;
  #undef CMASK
  #define CMASK(P0,P1,t) do{}while(0)
  for(;t+5<NT;t+=2){
    STEP(pB0,pB1,pA0,pA1,t,true,true,true);     PV2(); WAIT_BAR(3); RESC(); ROT();
    STEP(pA0,pA1,pB0,pB1,t+1,true,true,true);   PV2(); WAIT_BAR(3); RESC(); ROT();
  }
  #undef CMASK
  #define CMASK(P0,P1,t) do{int jb_=(t)-(NT-4); if(jb_>=0)cmask(P0,P1,jb_,qrel,hi);}while(0)
  #define ENDW(tt) do{ if((tt)+3<NT){WAIT_BAR(3);} else if((tt)+2<NT){WAIT_BAR(2);} else {WAIT_BAR(0);} }while(0)
  for(;t+1<NT;t+=2){
    STEP(pB0,pB1,pA0,pA1,t,(t+3<NT),(t+1<NT),(t+1<NT));       PV2(); ENDW(t);   RESC(); ROT();
    STEP(pA0,pA1,pB0,pB1,t+1,(t+4<NT),(t+2<NT),(t+2<NT));     PV2(); ENDW(t+1); RESC(); ROT();
  }
  STEP(pB0,pB1,pA0,pA1,NT-1,false,false,false); PV2(); RESC();
  { float sacc=pB0[0]+pB0[1]; _Pragma("unroll") for(int r=2;r<16;++r)sacc+=pB0[r]; _Pragma("unroll") for(int r=0;r<16;++r)sacc+=pB1[r]; l_reg+=sacc;
    pw0=(u32x4){PKW(pB0,0),PKW(pB0,2),PKW(pB0,4),PKW(pB0,6)};pw1=(u32x4){PKW(pB0,8),PKW(pB0,10),PKW(pB0,12),PKW(pB0,14)};pw2=(u32x4){PKW(pB1,0),PKW(pB1,2),PKW(pB1,4),PKW(pB1,6)};pw3=(u32x4){PKW(pB1,8),PKW(pB1,10),PKW(pB1,12),PKW(pB1,14)};
    SBAR(); pv(o,vb0+2*sl_cur,PAF(0),PAF(1),PAF(2),PAF(3)); SBAR(); pv(o2,vb0+2*sl_cur+8192,PAF(0),PAF(1),PAF(2),PAF(3)); }
  #undef PKW
  #undef PAF
  #undef VFR
  #undef PIN
  #undef MX3
  #undef GAPA
  #undef GAPB
  #undef EX
  #undef VRD
  #undef KRD
  #undef STEP
  #undef ENDW
  #undef PV2
  {auto rr=__builtin_amdgcn_permlane32_swap(__float_as_uint(l_reg),__float_as_uint(l_reg),false,false);l_reg=__uint_as_float(rr[0])+__uint_as_float(rr[1]);}
  if(hi==0)wsf[32+r32]=l_reg;asm volatile("s_waitcnt lgkmcnt(0)":::"memory");
  float rli[16];
  #pragma unroll
  for(int r=0;r<16;++r)rli[r]=__builtin_amdgcn_rcpf(wsf[32+crow(r,hi)]);
  bf16*Ow=Oh+(long)(q0+wid*QBLK)*opitch;
  { bf16*stg=(bf16*)(shm+LDS_OST)+wid*2048;
    #define OPASS(OO,COFF) do{ \
    _Pragma("unroll") for(int r=0;r<16;++r){const int orow=crow(r,hi); \
      _Pragma("unroll") for(int d0=0;d0<2;++d0)stg[orow*64+d0*32+r32]=__float2bfloat16(OO[d0][r]*rli[r]);} \
    asm volatile("s_waitcnt lgkmcnt(0)":::"memory"); \
    _Pragma("unroll") for(int i=0;i<4;++i){const int row=i*8+(lane>>3),ch=lane&7; const u32x4 v=*(const u32x4*)(stg+row*64+ch*8); ATTN_STORE16(Ow+(long)row*opitch+(COFF)+ch*8,v);} \
    asm volatile("s_waitcnt lgkmcnt(0)":::"memory"); }while(0)
    OPASS(o,0); OPASS(o2,64);
    #undef OPASS
  }
  asm volatile("s_waitcnt lgkmcnt(0)\n\ts_barrier":::"memory");
  #undef DMA_K
  #undef DMA_V
  #undef CMASK
  #undef START
  #undef RESC
  #undef ROT
}
constexpr int ATTN_LDS_BYTES=LDS_BYTES;
struct AttnTensors { const bf16* Q; const bf16* K; const bf16* V; bf16* O; };
struct AttnUnit { int bh; int qb; };
struct StaticOrder {
  int vcu;
  __device__ __forceinline__ explicit StaticOrder(int grid,int block):vcu((block%8)*(grid/8)+block/8){}
  __device__ __forceinline__ bool next(int i,AttnUnit&u)const{ if(i>=4)return false; const int s=vcu&15; u.bh=vcu>>4; const int ii=3-i; u.qb=(ii&1)?(32*(ii>>1)+31-s):(32*(ii>>1)+s); return true; }
  __device__ __forceinline__ void a_ready(const AttnUnit&)const{}
  __device__ __forceinline__ void done(const AttnUnit&)const{}
};
template<class Sched,int THRL=8> __device__ __forceinline__ void attn_phase(char*lds,const AttnTensors&T,const Sched&S,const int wave_s){
  AttnUnit u;
  for(int i=0;S.next(i,u);++i){ const int j=u.bh; attn_unit<THRL>(u.qb,T.Q+64*j,T.K+64*j,T.V+128*(j>>1),T.O+128*j,2048,lds,wave_s); }
}
#undef SBAR
#undef WAIT_BAR
}
#define GAS __attribute__((address_space(1)))
#define LAS __attribute__((address_space(3)))
typedef unsigned short bf16;
typedef unsigned v4u __attribute__((ext_vector_type(4)));
typedef unsigned v2u __attribute__((ext_vector_type(2)));
typedef float f32x4 __attribute__((ext_vector_type(4)));
typedef float f32x2 __attribute__((ext_vector_type(2)));
typedef short bf16x8 __attribute__((ext_vector_type(8)));
#define LDS_WAIT() asm volatile("s_waitcnt lgkmcnt(0)" ::: "memory")

constexpr int M = 16384, D = 1024, FF = 2816, NCHUNK = 256;
constexpr size_t MiB = 1u << 20;
constexpr size_t WS_WGU = 2 * MiB, WS_WD = 46 * MiB, WS_WGLU = 68 * MiB, WS_WIN = 76 * MiB, WS_WOG = 83 * MiB, WS_WQKV = 85 * MiB, WS_WOD = 91 * MiB;
constexpr size_t WS_S5P = 93 * MiB, WS_SSQ = 95 * MiB, WS_XN = 98 * MiB, WS_SCR = 130 * MiB, WS_END = 324 * MiB;
constexpr size_t S5P_LAM = 0, S5P_L64 = 32768, S5P_BB = 65536, S5P_CT = 65536 + 524288;
constexpr size_t SC_H = 0;
constexpr size_t SC_Z = 0, SC_SLOC = 32 * MiB, SC_CAR = 40 * MiB;
constexpr size_t SC_GQ = 0, SC_GK = 16 * MiB, SC_GV = 32 * MiB, SC_GSG = 64 * MiB, SC_GLA = 96 * MiB, SC_GUPD = 128 * MiB, SC_GDEC = 192 * MiB, SC_GO2 = SC_GV;
constexpr size_t SC_DQ = 0, SC_DK = 32 * MiB, SC_DV = 64 * MiB, SC_DO = 96 * MiB, SC_DOC = 160 * MiB;
static_assert(SC_GK == 16 * MiB && SC_GV == 32 * MiB && SC_GSG == 64 * MiB && SC_DK == 32 * MiB && SC_DV == 64 * MiB, "epilogue element offsets");
constexpr int LDS_BYTES = 147456;
constexpr int NWAVES = 8;
constexpr float LAMBDA_INIT = 0.4707130183435842f;

__device__ __forceinline__ unsigned f2bf(float f) { unsigned u = __builtin_bit_cast(unsigned, f); return (u + 0x7fffu + ((u >> 16) & 1u)) >> 16; }
__device__ __forceinline__ unsigned pk2(float lo, float hi) { return f2bf(lo) | (f2bf(hi) << 16); }
__device__ __forceinline__ float bf_lo(unsigned w) { return __builtin_bit_cast(float, w << 16); }
__device__ __forceinline__ float bf_hi(unsigned w) { return __builtin_bit_cast(float, w & 0xffff0000u); }
__device__ __forceinline__ float bf2f(bf16 b) { return __builtin_bit_cast(float, (unsigned)b << 16); }
__device__ __forceinline__ float wave_sum(float v) {
#pragma unroll
    for (int o = 1; o < 64; o <<= 1) v += shx(v, o);
    return v;
}

#define XB_TMO      128
#define XB_XCNT(j)  (256  + 64 * (j))
#define XB_XSUB(j)  (1280 + 64 * (j))
#define XB_XGEN(j)  (2304 + 64 * (j))
#define XB_TOP      3328
#define XB_TOPGEN   3392
#define XCD_BAR_WORDS 3456
#define XB_SPIN_CAP (1u << 18)

__device__ __forceinline__ unsigned xb_ld(unsigned* p)              { return __hip_atomic_load(p, __ATOMIC_RELAXED, __HIP_MEMORY_SCOPE_AGENT); }
__device__ __forceinline__ unsigned xb_add(unsigned* p, unsigned v) { return __hip_atomic_fetch_add(p, v, __ATOMIC_RELAXED, __HIP_MEMORY_SCOPE_AGENT); }
__device__ __forceinline__ unsigned xb_xcc_id() { return (unsigned)__builtin_amdgcn_s_getreg((3 << 11) | 20) & 0xFu; }
#define XB_SPIN(cond, bar) do { unsigned _sp = 0; while (cond) { __builtin_amdgcn_s_sleep(1); \
    if ((++_sp & 255u) == 0u) { if (xb_ld(&(bar)[XB_TMO])) break; if (_sp > XB_SPIN_CAP) { atomicAdd(&(bar)[XB_TMO], 1u); break; } } } } while (0)

struct XcdBarrier {
    unsigned* bar; unsigned x;
    volatile LAS unsigned* st;
};

__device__ __forceinline__ XcdBarrier xcd_barrier_post(unsigned* bar, volatile LAS unsigned* st) {
    XcdBarrier b; b.bar = bar; b.x = xb_xcc_id(); b.st = st;
    if (threadIdx.x == 0) (void)xb_add(&bar[XB_XCNT(b.x)], 1u);
    return b;
}
__device__ __forceinline__ void xcd_barrier_complete(unsigned* bar, unsigned x, unsigned& nloc, unsigned& nx) {
    const unsigned G = gridDim.x * gridDim.y * gridDim.z;
    unsigned sum, cnt, mine, sp = 0u;
    for (;;) {
        sum = 0u; cnt = 0u; mine = 0u;
#pragma unroll
        for (unsigned j = 0; j < 16; ++j) { const unsigned c = xb_ld(&bar[XB_XCNT(j)]); sum += c; cnt += (c > 0u) ? 1u : 0u; mine = (j == x) ? c : mine; }
        if (sum == G) break;
        __builtin_amdgcn_s_sleep(1);
        if ((++sp & 255u) == 0u) { if (xb_ld(&bar[XB_TMO])) break; if (sp > XB_SPIN_CAP) { atomicAdd(&bar[XB_TMO], 1u); break; } }
    }
    nloc = mine > 0u ? mine : 1u; nx = cnt > 0u ? cnt : 1u;
}

__device__ __forceinline__ void xcd_barrier(const XcdBarrier& b, const bool is_t0) {
    asm volatile("s_waitcnt vmcnt(0)" ::: "memory");
    __syncthreads();
    if (is_t0) {
        unsigned* bar = b.bar;
        __builtin_amdgcn_s_waitcnt(0);
        unsigned nloc = b.st[0], nx = b.st[1];
        if (nloc == 0u) { xcd_barrier_complete(bar, b.x, nloc, nx); b.st[0] = nloc; b.st[1] = nx; }
        const unsigned old = xb_add(&bar[XB_XSUB(b.x)], 1u);
        const unsigned gen = old / nloc;
        if (old + 1u == (gen + 1u) * nloc) {
            __builtin_amdgcn_fence(__ATOMIC_RELEASE, "agent");
            asm volatile("s_waitcnt vmcnt(0)" ::: "memory");
            const unsigned og = xb_add(&bar[XB_TOP], 1u);
            const unsigned tg = og / nx;
            if (og + 1u == (tg + 1u) * nx) xb_add(&bar[XB_TOPGEN], 1u);
            else XB_SPIN(xb_ld(&bar[XB_TOPGEN]) == tg, bar);
            __builtin_amdgcn_fence(__ATOMIC_ACQUIRE, "agent");
            xb_add(&bar[XB_XGEN(b.x)], 1u);
            asm volatile("s_waitcnt vmcnt(0)" ::: "memory");
        } else {
            XB_SPIN(xb_ld(&bar[XB_XGEN(b.x)]) == gen, bar);
            __builtin_amdgcn_fence(__ATOMIC_ACQUIRE, "agent");
            asm volatile("s_waitcnt vmcnt(0)" ::: "memory");
        }
    }
    __syncthreads();
}

constexpr size_t WS_BAR = 1 * MiB + 65536;
constexpr int MISC_OFF = 147456 - 256;

struct Args {
    const float* x; const int* pos; const float *norm_mix, *norm_ffn, *norm_final;
    const float *s5_lam_re, *s5_lam_im, *s5_log_dt, *s5_b_re, *s5_b_im, *s5_c_re, *s5_c_im, *s5_d, *s5_w_glu;
    const float *gla_w_in, *gla_w_a2, *gla_b_a, *gla_norm, *gla_w_o;
    const float *diff_w_qkv, *diff_lq1, *diff_lk1, *diff_lq2, *diff_lk2, *diff_subln, *diff_w_o;
    const float *ffn_w_gu, *ffn_w_d;
    float* out; unsigned char* ws;
};

#define KA(f) (*(volatile const __attribute__((address_space(4))) decltype(Args::f)*)((const __attribute__((address_space(4))) char*)__builtin_amdgcn_kernarg_segment_ptr() + offsetof(Args, f)))
__device__ __forceinline__ void transpose_item(const float* W, int ldw, int K, bf16* WT, int k0, int n0, int drow0, LAS float* scr, int lane, const float* gsc) {
    float wv[32];
    const float* wp = W + (size_t)(k0 + (lane >> 5)) * ldw + n0 + (lane & 31);
#pragma unroll
    for (int i = 0; i < 32; ++i) wv[i] = __builtin_nontemporal_load(wp + (size_t)(2 * i) * ldw);
    if (gsc) {
#pragma unroll
        for (int i = 0; i < 32; ++i) wv[i] *= gsc[k0 + 2 * i + (lane >> 5)]; }
#pragma unroll
    for (int i = 0; i < 32; ++i) scr[(2 * i + (lane >> 5)) * 33 + (lane & 31)] = wv[i];
    LDS_WAIT();
    const int c = lane & 7;
#pragma unroll
    for (int j = 0; j < 4; ++j) { const int n = (lane >> 3) + 8 * j; const LAS float* s = scr + (8 * c) * 33 + n;
        v4u o; o.x = pk2(s[0 * 33], s[1 * 33]); o.y = pk2(s[2 * 33], s[3 * 33]); o.z = pk2(s[4 * 33], s[5 * 33]); o.w = pk2(s[6 * 33], s[7 * 33]);
        *(v4u*)(WT + (size_t)(drow0 + n) * K + k0 + 8 * c) = o; }
    LDS_WAIT();
}

__device__ __forceinline__ void convert_set(const int set, const int wk, const int nwk, const int wblk, const int nwblk, LAS unsigned char* lds, int tid, int lane, int wave) {
    unsigned char* ws = KA(ws);
    LAS float* scr = (LAS float*)(lds + wave * 16384);
    constexpr int I_GU = 16 * 176, I_D = 44 * 32, I_GLU = 16 * 64, I_IN = 16 * 96, I_SQ = 16 * 32;
    const bool s5set = (set == 0 || set == 3);
    const int nitems = I_GU + I_D + (s5set ? I_GLU : I_IN + I_SQ);
    for (int it = wk; it < nitems; it += nwk) {
        int r = it; const float* W; bf16* WT; int ldw, K, ncols, inter = 0; const float* gsc = nullptr;
        if (r < I_GU) { W = KA(ffn_w_gu) + (size_t)set * 1024 * 5632; WT = (bf16*)(ws + WS_WGU) + (size_t)set * 5632 * 1024; ldw = 5632; K = 1024; ncols = 5632; inter = 2816; gsc = KA(norm_ffn) + set * 1024; }
        else if ((r -= I_GU) < I_D) { W = KA(ffn_w_d) + (size_t)set * 2816 * 1024; WT = (bf16*)(ws + WS_WD) + (size_t)set * 1024 * 2816; ldw = 1024; K = 2816; ncols = 1024; }
        else { r -= I_D;
            if (s5set) { const int L = (set == 3) ? 1 : 0; W = KA(s5_w_glu) + (size_t)L * 1024 * 2048; WT = (bf16*)(ws + WS_WGLU) + (size_t)L * 2048 * 1024; ldw = 2048; K = 1024; ncols = 2048; inter = 1024; }
            else if (set == 1) { if (r < I_IN) { W = KA(gla_w_in); WT = (bf16*)(ws + WS_WIN); ldw = 3088; K = 1024; ncols = 3072; gsc = KA(norm_mix) + 1 * 1024; }
                                 else { r -= I_IN; W = KA(gla_w_o); WT = (bf16*)(ws + WS_WOG); ldw = 1024; K = 1024; ncols = 1024; } }
            else { if (r < I_IN) { W = KA(diff_w_qkv); WT = (bf16*)(ws + WS_WQKV); ldw = 3072; K = 1024; ncols = 3072; gsc = KA(norm_mix) + 2 * 1024; }
                   else { r -= I_IN; W = KA(diff_w_o); WT = (bf16*)(ws + WS_WOD); ldw = 1024; K = 1024; ncols = 1024; } }
        }
        const int nblk = ncols / 32, kb = r / nblk, nb = r - kb * nblk, n0 = nb * 32;
        int drow0 = n0;
        if (inter) { if (n0 < inter) drow0 = 256 * (n0 >> 7) + (n0 & 127); else { const int n1 = n0 - inter; drow0 = 256 * (n1 >> 7) + 128 + (n1 & 127); } }
        transpose_item(W, ldw, K, WT, kb * 64, n0, drow0, scr, lane, gsc);
    }
    if (set == 1) {
        bf16* WT = (bf16*)(ws + WS_WIN) + (size_t)3072 * 1024;
        for (int e = wblk * 512 + tid; e < 512 * 1024; e += nwblk * 512) {
            const int k = e & 1023, j = e >> 10; float s = 0.f;
            const float* wi = KA(gla_w_in) + (size_t)k * 3088 + 3072;
#pragma unroll
            for (int r = 0; r < 16; ++r) s += wi[r] * KA(gla_w_a2)[r * 512 + j];
            WT[(size_t)j * 1024 + k] = (bf16)f2bf(s * KA(norm_mix)[1024 + k]);
        }
    }
}
__device__ __forceinline__ void prologue(LAS unsigned char* lds, int tid, int lane, int wave) {
    unsigned char* ws = KA(ws);
    const int gw = blockIdx.x * NWAVES + wave, NGW = gridDim.x * NWAVES;
    convert_set(0, gw, NGW, (int)blockIdx.x, (int)gridDim.x, lds, tid, lane, wave);
    {
        bf16* XN = (bf16*)(ws + WS_XN); float* SSQ = (float*)(ws + WS_SSQ);
        const float* xin = KA(x);
        for (int m = 2 * gw; m < M; m += 2 * NGW) {
            const f32x4* xr = (const f32x4*)(xin + (size_t)m * D) + lane;
            f32x4 v[8];
#pragma unroll
            for (int j = 0; j < 8; ++j) v[j] = __builtin_nontemporal_load(xr + 64 * j);
#pragma unroll
            for (int rr = 0; rr < 2; ++rr) { float s = 0.f; v2u* o8 = (v2u*)(XN + (size_t)(m + rr) * D) + lane;
#pragma unroll
                for (int j = 0; j < 4; ++j) { const f32x4 x4 = v[4 * rr + j]; s += (x4[0] * x4[0] + x4[1] * x4[1]) + (x4[2] * x4[2] + x4[3] * x4[3]);
                    v2u w; w.x = pk2(x4[0], x4[1]); w.y = pk2(x4[2], x4[3]); o8[64 * j] = w; }
                s = wave_sum(s);
                if (lane < 32) SSQ[(size_t)(m + rr) * 32 + lane] = (lane == 0) ? s : 0.f; }
        }
    }
    for (int e = blockIdx.x * 512 + tid; e < 2 * 4096; e += gridDim.x * 512) {
        const int li = e >> 12, gp = e & 4095, g = gp >> 6, p = gp & 63;
        unsigned char* pb = ws + WS_S5P + (size_t)li * MiB;
        const double lr = (double)KA(s5_lam_re)[li * 4096 + gp], lim = (double)KA(s5_lam_im)[li * 4096 + gp], dt = exp((double)KA(s5_log_dt)[li * 64 + g]);
        const double mag = exp(lr * dt), ang = lim * dt, abr = mag * cos(ang), abi = mag * sin(ang);
        const double den = lr * lr + lim * lim, fre = ((abr - 1.0) * lr + abi * lim) / den, fim = (abi * lr - (abr - 1.0) * lim) / den;
        const double mag64 = exp(lr * dt * 64.0), ang64 = lim * dt * 64.0;
        ((f32x2*)(pb + S5P_LAM))[gp] = (f32x2){(float)abr, (float)abi};
        ((f32x2*)(pb + S5P_L64))[gp] = (f32x2){(float)(mag64 * cos(ang64)), (float)(mag64 * sin(ang64))};
        bf16* BBh = (bf16*)(pb + S5P_BB);
        const float* bre = KA(s5_b_re) + ((size_t)li * 4096 + gp) * 16; const float* bim = KA(s5_b_im) + ((size_t)li * 4096 + gp) * 16;
#pragma unroll
        for (int h = 0; h < 16; ++h) { const double gk = (double)KA(norm_mix)[(li * 3) * 1024 + 16 * g + h]; const double br = (double)bre[h] * gk, bi = (double)bim[h] * gk;
            BBh[(g * 128 + p) * 16 + h] = (bf16)f2bf((float)(fre * br - fim * bi)); BBh[(g * 128 + 64 + p) * 16 + h] = (bf16)f2bf((float)(fre * bi + fim * br)); }
        bf16* CT = (bf16*)(pb + S5P_CT);
#pragma unroll
        for (int h = 0; h < 16; ++h) { const size_t ci = (((size_t)li * 64 + g) * 16 + h) * 64 + p;
            CT[(g * 16 + h) * 128 + 2 * p] = (bf16)f2bf(KA(s5_c_re)[ci]); CT[(g * 16 + h) * 128 + 2 * p + 1] = (bf16)f2bf(-KA(s5_c_im)[ci]); }
    }
}

typedef short s16x4 __attribute__((ext_vector_type(4)));
__device__ __forceinline__ void s5_rstd_table(const float* SSQ, int c, int tid, LAS float* rstdL) {
    __syncthreads();
    if (tid < 64) { const f32x4* p = (const f32x4*)(SSQ + (size_t)(64 * c + tid) * 32); float s = 0.f;
#pragma unroll
        for (int i = 0; i < 8; ++i) { const f32x4 v = p[i]; s += (v[0] + v[1]) + (v[2] + v[3]); }
        rstdL[tid] = __builtin_amdgcn_rsqf(s * (1.0f / 1024.0f) + 1e-6f); }
    __syncthreads();
}
__device__ __forceinline__ void s5_bu_block(const s16x4 av, const s16x4 (&bw)[8], const LAS float* rstdL, int tb, LAS float* BU, int col, int quad) {
    const f32x4 rs = *(const LAS f32x4*)(rstdL + 16 * tb + 4 * quad);
#pragma unroll
    for (int nt = 0; nt < 8; ++nt) {
        f32x4 d = __builtin_amdgcn_mfma_f32_16x16x16bf16_1k(av, bw[nt], (f32x4){0.f, 0.f, 0.f, 0.f}, 0, 0, 0);
        *(LAS f32x4*)(BU + (16 * nt + col) * 20 + 4 * quad) = d * rs;
    }
    LDS_WAIT();
}
struct S5Ops { s16x4 av[4]; s16x4 bw[8]; f32x2 lam; };
__device__ __forceinline__ void s5_load_ops(S5Ops& o, const bf16* XN, const bf16* BBh, const f32x2* LAM, int c, int g, int lane, int col, int quad) {
#pragma unroll
    for (int tb = 0; tb < 4; ++tb) o.av[tb] = *(const s16x4*)(XN + (size_t)(64 * c + 16 * tb + col) * D + 16 * g + 4 * quad);
#pragma unroll
    for (int nt = 0; nt < 8; ++nt) o.bw[nt] = *(const s16x4*)(BBh + (size_t)(g * 128 + 16 * nt + col) * 16 + 4 * quad);
    o.lam = LAM[g * 64 + lane];
}
__device__ __forceinline__ void s5_phaseA(const unsigned char* pb, const bf16* XN, const float* SSQ, f32x2* SLOC, LAS unsigned char* lds, int tid, int lane, int wave) {
    LAS float* rstdL = (LAS float*)lds; LAS float* BU = (LAS float*)(lds + 1024 + wave * 14592);
    const f32x2* LAM = (const f32x2*)(pb + S5P_LAM); const bf16* BBh = (const bf16*)(pb + S5P_BB);
    const int col = lane & 15, quad = lane >> 4;
    for (int c = blockIdx.x; c < NCHUNK; c += gridDim.x) {
        S5Ops cur; s5_load_ops(cur, XN, BBh, LAM, c, wave * 8, lane, col, quad);
        s5_rstd_table(SSQ, c, tid, rstdL);
        for (int gi = 0; gi < 8; ++gi) {
            const int g = wave * 8 + gi;
            S5Ops nxt; s5_load_ops(nxt, XN, BBh, LAM, c, wave * 8 + ((gi + 1) & 7), lane, col, quad);
            float sre = 0.f, sim = 0.f;
#pragma unroll
            for (int tb = 0; tb < 4; ++tb) {
                s5_bu_block(cur.av[tb], cur.bw, rstdL, tb, BU, col, quad);
#pragma unroll
                for (int t4 = 0; t4 < 4; ++t4) { const f32x4 br4 = *(const LAS f32x4*)(BU + lane * 20 + 4 * t4), bi4 = *(const LAS f32x4*)(BU + (64 + lane) * 20 + 4 * t4);
#pragma unroll
                    for (int q = 0; q < 4; ++q) { const float nre = cur.lam[0] * sre - cur.lam[1] * sim + br4[q], nim = cur.lam[0] * sim + cur.lam[1] * sre + bi4[q]; sre = nre; sim = nim; } }
                LDS_WAIT();
            }
            SLOC[(size_t)(c * 64 + g) * 64 + lane] = (f32x2){sre, sim};
            cur = nxt;
        }
    }
}
__device__ __forceinline__ f32x2 cmul(const f32x2 a, const f32x2 b) { return (f32x2){a[0] * b[0] - a[1] * b[1], a[0] * b[1] + a[1] * b[0]}; }
__device__ __forceinline__ void s5_phaseB(const unsigned char* pb, const f32x2* SLOC, f32x2* CAR, LAS unsigned char* lds, int tid) {
    LAS f32x2* EX = (LAS f32x2*)lds;
    const int gl = tid & 31, seg = tid >> 5;
    for (int it = blockIdx.x; it < 128; it += gridDim.x) {
        const int gid = it * 32 + gl; const f32x2 l = ((const f32x2*)(pb + S5P_L64))[gid];
        f32x2 v[16];
#pragma unroll
        for (int i = 0; i < 16; ++i) v[i] = SLOC[(size_t)(16 * seg + i) * 4096 + gid];
        f32x2 s = (f32x2){0.f, 0.f};
#pragma unroll
        for (int i = 0; i < 16; ++i) { const f32x2 in = s; s = cmul(l, s) + v[i]; v[i] = in; }
        __syncthreads();
        EX[seg * 32 + gl] = s;
        __syncthreads();
        f32x2 l16 = cmul(l, l); l16 = cmul(l16, l16); l16 = cmul(l16, l16); l16 = cmul(l16, l16);
        f32x2 S = (f32x2){0.f, 0.f};
#pragma unroll
        for (int sp = 0; sp < 15; ++sp) { const f32x2 e = EX[sp * 32 + gl]; if (sp < seg) S = cmul(l16, S) + e; }
        f32x2 p = (f32x2){1.f, 0.f};
#pragma unroll
        for (int i = 0; i < 16; ++i) { CAR[(size_t)(16 * seg + i) * 4096 + gid] = v[i] + cmul(p, S); p = cmul(p, l); }
    }
}
struct S5OpsC { bf16x8 cf[4]; f32x2 s0; float dsk; };
__device__ __forceinline__ void s5_load_opsC(S5OpsC& o, const bf16* XN, const bf16* CT, const f32x2* CAR, const float* dskip, const float* gmix, int c, int g, int lane, int col, int quad) {
#pragma unroll
    for (int ks = 0; ks < 4; ++ks) o.cf[ks] = *(const bf16x8*)(CT + (g * 16 + col) * 128 + 32 * ks + 8 * quad);
    o.s0 = CAR[(size_t)(c * 64 + g) * 64 + lane]; o.dsk = dskip[16 * g + col] * gmix[16 * g + col];
}
__device__ __forceinline__ void s5_phaseC(const unsigned char* pb, const bf16* XN, const float* SSQ, const f32x2* CAR, const float* dskip, const float* gmix, bf16* Z, LAS unsigned char* lds, int tid, int lane, int wave) {
    LAS float* rstdL = (LAS float*)lds; LAS float* BU = (LAS float*)(lds + 1024 + wave * 14592); LAS unsigned* SL = (LAS unsigned*)(lds + 1024 + wave * 14592 + 10240);
    LAS bf16* HT = (LAS bf16*)(lds + 1024 + 8 * 14592 + wave * 2048);
    const f32x2* LAM = (const f32x2*)(pb + S5P_LAM); const bf16* BBh = (const bf16*)(pb + S5P_BB); const bf16* CT = (const bf16*)(pb + S5P_CT);
    const int col = lane & 15, quad = lane >> 4;
    for (int c = blockIdx.x; c < NCHUNK; c += gridDim.x) {
        S5Ops cur; S5OpsC curc; s5_load_ops(cur, XN, BBh, LAM, c, wave * 8, lane, col, quad); s5_load_opsC(curc, XN, CT, CAR, dskip, gmix, c, wave * 8, lane, col, quad);
        s5_rstd_table(SSQ, c, tid, rstdL);
        for (int gi = 0; gi < 8; ++gi) {
            const int g = wave * 8 + gi, gn = wave * 8 + ((gi + 1) & 7);
            S5Ops nxt; S5OpsC nxtc; s5_load_ops(nxt, XN, BBh, LAM, c, gn, lane, col, quad); s5_load_opsC(nxtc, XN, CT, CAR, dskip, gmix, c, gn, lane, col, quad);
            float sre = curc.s0[0], sim = curc.s0[1];
#pragma unroll
            for (int tb = 0; tb < 4; ++tb) *(LAS s16x4*)(HT + (16 * tb + col) * 16 + 4 * quad) = cur.av[tb];
#pragma unroll
            for (int tb = 0; tb < 4; ++tb) {
                s5_bu_block(cur.av[tb], cur.bw, rstdL, tb, BU, col, quad);
#pragma unroll
                for (int t4 = 0; t4 < 4; ++t4) { const f32x4 br4 = *(const LAS f32x4*)(BU + lane * 20 + 4 * t4), bi4 = *(const LAS f32x4*)(BU + (64 + lane) * 20 + 4 * t4);
#pragma unroll
                    for (int q = 0; q < 4; ++q) { const float nre = cur.lam[0] * sre - cur.lam[1] * sim + br4[q], nim = cur.lam[0] * sim + cur.lam[1] * sre + bi4[q]; sre = nre; sim = nim;
                        SL[(4 * t4 + q) * 68 + lane] = pg8::cvt_pk_bf16(sre, sim); } }
                LDS_WAIT();
                f32x4 acc = (f32x4){0.f, 0.f, 0.f, 0.f};
#pragma unroll
                for (int ks = 0; ks < 4; ++ks) { const bf16x8 a8 = *(const LAS bf16x8*)((const LAS unsigned char*)SL + col * 272 + 64 * ks + 16 * quad); acc = __builtin_amdgcn_mfma_f32_16x16x32_bf16(a8, curc.cf[ks], acc, 0, 0, 0); }
                const f32x4 rs = *(const LAS f32x4*)(rstdL + 16 * tb + 4 * quad);
#pragma unroll
                for (int j = 0; j < 4; ++j) { const int tl = 16 * tb + 4 * quad + j; const float y = acc[j] + curc.dsk * (bf2f(HT[tl * 16 + col]) * rs[j]);
                    const float a2 = 1.5957691216057308f * (y + 0.044715f * y * y * y); const float z = y * __builtin_amdgcn_rcpf(1.0f + __builtin_amdgcn_exp2f(-1.4426950408889634f * a2));
                    Z[(size_t)(64 * c + tl) * D + 16 * g + col] = (bf16)f2bf(z); }
                LDS_WAIT();
            }
            cur = nxt; curc = nxtc;
        }
    }
}

__device__ __forceinline__ void gla_g1(const bf16* Kb, const bf16* Vb, const float* LA, bf16* UPD, float* DEC, LAS unsigned char* lds, int tid, int lane, int wave) {
    LAS bf16* KD = (LAS bf16*)lds; LAS bf16* VT = (LAS bf16*)(lds + 18432);
    LAS float* SEG = (LAS float*)(lds + 55296);
    LAS bf16* OST = (LAS bf16*)(lds + 57344 + wave * 8704);
    const int col = lane & 15, quad = lane >> 4;
    for (int item = blockIdx.x; item < 1024; item += gridDim.x) {
        const int c = item >> 2, h = item & 3;
        const int dk = tid & 127, tq = tid >> 7, dv = tid & 255, th = tid >> 8;
        float la[16]; unsigned short kk[16], vv[32];
#pragma unroll
        for (int i = 0; i < 16; ++i) { const size_t r = (size_t)(64 * c + 16 * tq + i) * 512 + 128 * h + dk; la[i] = LA[r]; kk[i] = Kb[r]; }
#pragma unroll
        for (int i = 0; i < 32; ++i) vv[i] = Vb[(size_t)(64 * c + 32 * th + i) * 1024 + 256 * h + dv];
        __syncthreads();
#pragma unroll
        for (int i = 1; i < 16; ++i) la[i] += la[i - 1];
        SEG[tq * 128 + dk] = la[15];
#pragma unroll
        for (int i8 = 0; i8 < 4; ++i8) { v4u w; w.x = vv[8 * i8] | ((unsigned)vv[8 * i8 + 1] << 16); w.y = vv[8 * i8 + 2] | ((unsigned)vv[8 * i8 + 3] << 16);
            w.z = vv[8 * i8 + 4] | ((unsigned)vv[8 * i8 + 5] << 16); w.w = vv[8 * i8 + 6] | ((unsigned)vv[8 * i8 + 7] << 16);
            *(LAS v4u*)(VT + dv * 72 + 32 * th + 8 * i8) = w; }
        __syncthreads();
        { const float s0 = SEG[dk], s1 = SEG[128 + dk], s2 = SEG[256 + dk], s3 = SEG[384 + dk];
          const float off = (tq > 0 ? s0 : 0.f) + (tq > 1 ? s1 : 0.f) + (tq > 2 ? s2 : 0.f); const float tot = (s0 + s1) + (s2 + s3);
          if (tq == 0) DEC[(c * 4 + h) * 128 + dk] = __expf(tot);
          float kd[16];
#pragma unroll
          for (int i = 0; i < 16; ++i) kd[i] = bf2f(kk[i]) * __expf(tot - (off + la[i]));
#pragma unroll
          for (int i8 = 0; i8 < 2; ++i8) { v4u w; w.x = pk2(kd[8 * i8], kd[8 * i8 + 1]); w.y = pk2(kd[8 * i8 + 2], kd[8 * i8 + 3]); w.z = pk2(kd[8 * i8 + 4], kd[8 * i8 + 5]); w.w = pk2(kd[8 * i8 + 6], kd[8 * i8 + 7]);
              *(LAS v4u*)(KD + dk * 72 + 16 * tq + 8 * i8) = w; } }
        __syncthreads();
        bf16x8 bfr[2][2];
#pragma unroll
        for (int n2 = 0; n2 < 2; ++n2)
#pragma unroll
            for (int ks = 0; ks < 2; ++ks) bfr[n2][ks] = *(const LAS bf16x8*)(VT + (16 * (2 * wave + n2) + col) * 72 + 32 * ks + 8 * quad);
#pragma unroll
        for (int mt = 0; mt < 8; ++mt) {
            const bf16x8 a0 = *(const LAS bf16x8*)(KD + (16 * mt + col) * 72 + 8 * quad), a1 = *(const LAS bf16x8*)(KD + (16 * mt + col) * 72 + 32 + 8 * quad);
#pragma unroll
            for (int n2 = 0; n2 < 2; ++n2) {
                f32x4 acc = (f32x4){0.f, 0.f, 0.f, 0.f};
                acc = __builtin_amdgcn_mfma_f32_16x16x32_bf16(a0, bfr[n2][0], acc, 0, 0, 0); acc = __builtin_amdgcn_mfma_f32_16x16x32_bf16(a1, bfr[n2][1], acc, 0, 0, 0);
                v2u w; w.x = pk2(acc[0], acc[1]); w.y = pk2(acc[2], acc[3]);
                *(LAS v2u*)(OST + (16 * n2 + col) * 136 + 16 * mt + 4 * quad) = w;
            }
        }
        LDS_WAIT();
        bf16* out = UPD + ((size_t)(c * 4 + h) * 256 + 32 * wave) * 128;
#pragma unroll
        for (int i = 0; i < 8; ++i) { const int row = 4 * i + (lane >> 4), ch = lane & 15; const v4u v = *(const LAS v4u*)(OST + row * 136 + 8 * ch); *(v4u*)(out + (size_t)row * 128 + 8 * ch) = v; }
    }
}
__device__ __forceinline__ void gla_g2(bf16* UPD, const float* DEC, LAS unsigned char* lds, int tid) {
    LAS f32x4* EX = (LAS f32x4*)lds;
    const unsigned el = (unsigned)tid & 31u, seg = ((unsigned)tid >> 5) & 15u;
    for (unsigned it = blockIdx.x; it < 1024u; it += gridDim.x) {
        const unsigned e = ((it * 32u + el) * 4u) & 131071u, dk = e & 127u, h = e >> 15;
        const unsigned o0 = (16u * seg) * 131072u + e, q0 = (16u * seg * 4u + h) * 128u + dk;
        f32x4 u[16], d[16];
#pragma unroll
        for (unsigned i = 0; i < 16; ++i) { const v2u w = __builtin_nontemporal_load((const v2u*)(UPD + o0 + i * 131072u)); u[i] = (f32x4){bf_lo(w.x), bf_hi(w.x), bf_lo(w.y), bf_hi(w.y)}; d[i] = *(const f32x4*)(DEC + q0 + i * 512u); }
        f32x4 st = (f32x4){0.f, 0.f, 0.f, 0.f}, cp = (f32x4){1.f, 1.f, 1.f, 1.f};
#pragma unroll
        for (int i = 0; i < 16; ++i) { st = d[i] * st + u[i]; cp = cp * d[i]; u[i] = st; d[i] = cp; }
        __syncthreads();
        EX[(seg * 32 + el) * 2] = st; EX[(seg * 32 + el) * 2 + 1] = cp;
        __syncthreads();
        f32x4 S = (f32x4){0.f, 0.f, 0.f, 0.f};
#pragma unroll
        for (unsigned sp = 0; sp < 15; ++sp) { const f32x4 es = EX[(sp * 32 + el) * 2], ec = EX[(sp * 32 + el) * 2 + 1]; if (sp < seg) S = ec * S + es; }
#pragma unroll
        for (unsigned i = 0; i < 16; ++i) { const f32x4 r = u[i] + d[i] * S; v2u w; w.x = pk2(r[0], r[1]); w.y = pk2(r[2], r[3]); *(v2u*)(UPD + o0 + i * 131072u) = w; }
    }
}
__device__ __forceinline__ void gla_g3(const bf16* Qb, const bf16* ST, const bf16* SG, const float* gnorm, bf16* O2, LAS unsigned char* lds, int tid, int lane, int wave) {
    LAS float* P = (LAS float*)lds;
    const int col = lane & 15, quad = lane >> 4;
    for (int item = blockIdx.x; item < 1024; item += gridDim.x) {
        const int c = item >> 2, h = item & 3;
        const bf16* st = ST + (size_t)(c * 4 + h) * 256 * 128;
        bf16x8 af[2][4];
#pragma unroll
        for (int m2 = 0; m2 < 2; ++m2)
#pragma unroll
            for (int ks = 0; ks < 4; ++ks) af[m2][ks] = *(const bf16x8*)(st + (size_t)(16 * (2 * wave + m2) + col) * 128 + 32 * ks + 8 * quad);
        v2u sgv[2][4]; f32x4 ngv[2];
#pragma unroll
        for (int m2 = 0; m2 < 2; ++m2) { const int dv0 = 16 * (2 * wave + m2) + 4 * quad; ngv[m2] = *(const f32x4*)(gnorm + 256 * h + dv0);
#pragma unroll
            for (int nt = 0; nt < 4; ++nt) sgv[m2][nt] = *(const v2u*)(SG + (size_t)(64 * c + 16 * nt + col) * 1024 + 256 * h + dv0); }
        f32x4 acc[2][4];
#pragma unroll
        for (int nt = 0; nt < 4; ++nt) {
            bf16x8 bq[4];
#pragma unroll
            for (int ks = 0; ks < 4; ++ks) bq[ks] = *(const bf16x8*)(Qb + (size_t)(64 * c + 16 * nt + col) * 512 + 128 * h + 32 * ks + 8 * quad);
#pragma unroll
            for (int m2 = 0; m2 < 2; ++m2) { f32x4 r = (f32x4){0.f, 0.f, 0.f, 0.f};
#pragma unroll
                for (int ks = 0; ks < 4; ++ks) r = __builtin_amdgcn_mfma_f32_16x16x32_bf16(af[m2][ks], bq[ks], r, 0, 0, 0);
                acc[m2][nt] = r; }
        }
        __syncthreads();
#pragma unroll
        for (int nt = 0; nt < 4; ++nt) { float s = 0.f;
#pragma unroll
            for (int m2 = 0; m2 < 2; ++m2) { const f32x4 r = acc[m2][nt]; s += (r[0] * r[0] + r[1] * r[1]) + (r[2] * r[2] + r[3] * r[3]); }
            s += shx(s, 16); s += shx(s, 32);
            if (quad == 0) P[(16 * nt + col) * 8 + wave] = s; }
        __syncthreads();
#pragma unroll
        for (int nt = 0; nt < 4; ++nt) { const int t = 16 * nt + col; const LAS f32x4* pp = (const LAS f32x4*)(P + t * 8); const f32x4 p0 = pp[0], p1 = pp[1];
            const float tot = ((p0[0] + p0[1]) + (p0[2] + p0[3])) + ((p1[0] + p1[1]) + (p1[2] + p1[3])); const float rs = __builtin_amdgcn_rsqf(tot * (1.0f / 256.0f) + 1e-6f);
#pragma unroll
            for (int m2 = 0; m2 < 2; ++m2) { const int dv0 = 16 * (2 * wave + m2) + 4 * quad; const f32x4 ng = ngv[m2];
                const size_t off = (size_t)(64 * c + t) * 1024 + 256 * h + dv0; const v2u sg = sgv[m2][nt]; const f32x4 r = acc[m2][nt];
                v2u w; w.x = pk2(r[0] * rs * ng[0] * bf_lo(sg.x), r[1] * rs * ng[1] * bf_hi(sg.x)); w.y = pk2(r[2] * rs * ng[2] * bf_lo(sg.y), r[3] * rs * ng[3] * bf_hi(sg.y));
                *(v2u*)(O2 + off) = w; } }
    }
}

__device__ __forceinline__ void diff_combine(const bf16* O, bf16* OC, int lane, int wave) {
    const float s1 = wave_sum(KA(diff_lq1)[lane] * KA(diff_lk1)[lane]), s2 = wave_sum(KA(diff_lq2)[lane] * KA(diff_lk2)[lane]);
    const float lamv = __expf(s1) - __expf(s2) + LAMBDA_INIT;
    const int h = lane >> 3, d0 = 16 * (lane & 7);
    f32x4 sg[4];
#pragma unroll
    for (int i = 0; i < 4; ++i) sg[i] = *(const f32x4*)(KA(diff_subln) + d0 + 4 * i);
    const int gw = blockIdx.x * NWAVES + wave, NGW = gridDim.x * NWAVES;
    for (int m = gw; m < M; m += NGW) {
        const v4u* p1 = (const v4u*)(O + (size_t)m * 2048 + 256 * h + d0); const v4u* p2 = (const v4u*)(O + (size_t)m * 2048 + 256 * h + 128 + d0);
        const v4u a0 = __builtin_nontemporal_load(p1), a1 = __builtin_nontemporal_load(p1 + 1), b0 = __builtin_nontemporal_load(p2), b1 = __builtin_nontemporal_load(p2 + 1);
        float d[16];
#define DC(i, wa, wb) d[2 * (i)] = bf_lo(wa) - lamv * bf_lo(wb); d[2 * (i) + 1] = bf_hi(wa) - lamv * bf_hi(wb);
        DC(0, a0.x, b0.x) DC(1, a0.y, b0.y) DC(2, a0.z, b0.z) DC(3, a0.w, b0.w) DC(4, a1.x, b1.x) DC(5, a1.y, b1.y) DC(6, a1.z, b1.z) DC(7, a1.w, b1.w)
#undef DC
        float s = 0.f;
#pragma unroll
        for (int i = 0; i < 16; ++i) s += d[i] * d[i];
        s += shx(s, 1); s += shx(s, 2); s += shx(s, 4);
        const float r = __builtin_amdgcn_rsqf(s * (1.0f / 128.0f) + 1e-5f) * (1.0f - LAMBDA_INIT);
        v4u w0, w1;
        w0.x = pk2(d[0] * r * sg[0][0], d[1] * r * sg[0][1]); w0.y = pk2(d[2] * r * sg[0][2], d[3] * r * sg[0][3]); w0.z = pk2(d[4] * r * sg[1][0], d[5] * r * sg[1][1]); w0.w = pk2(d[6] * r * sg[1][2], d[7] * r * sg[1][3]);
        w1.x = pk2(d[8] * r * sg[2][0], d[9] * r * sg[2][1]); w1.y = pk2(d[10] * r * sg[2][2], d[11] * r * sg[2][3]); w1.z = pk2(d[12] * r * sg[3][0], d[13] * r * sg[3][1]); w1.w = pk2(d[14] * r * sg[3][2], d[15] * r * sg[3][3]);
        v4u* o = (v4u*)(OC + (size_t)m * 1024 + 128 * h + d0); o[0] = w0; o[1] = w1;
    }
}
__device__ __forceinline__ void final_norm(const bf16* XB, float* out, const float* g, int lane, int wave) {
    const int gw = blockIdx.x * NWAVES + wave, NGW = gridDim.x * NWAVES;
    const f32x4* gr = (const f32x4*)g + 2 * lane;
    for (int m = 2 * gw; m < M; m += 2 * NGW) {
        const v4u* xr = (const v4u*)(XB + (size_t)m * D) + lane;
        v4u w[4];
#pragma unroll
        for (int j = 0; j < 4; ++j) w[j] = __builtin_nontemporal_load(xr + 64 * j);
#pragma unroll
        for (int rr = 0; rr < 2; ++rr) { float x[16]; float s = 0.f;
#pragma unroll
            for (int hf = 0; hf < 2; ++hf) { const v4u q = w[2 * rr + hf];
                x[8 * hf + 0] = bf_lo(q.x); x[8 * hf + 1] = bf_hi(q.x); x[8 * hf + 2] = bf_lo(q.y); x[8 * hf + 3] = bf_hi(q.y); x[8 * hf + 4] = bf_lo(q.z); x[8 * hf + 5] = bf_hi(q.z); x[8 * hf + 6] = bf_lo(q.w); x[8 * hf + 7] = bf_hi(q.w); }
#pragma unroll
            for (int i = 0; i < 16; ++i) s += x[i] * x[i];
            const float rs = 1.0f / sqrtf(wave_sum(s) * (1.0f / D) + 1e-6f);
            f32x4* o = (f32x4*)(out + (size_t)(m + rr) * D) + 2 * lane;
#pragma unroll
            for (int hf = 0; hf < 2; ++hf) { const f32x4 g0 = gr[128 * hf], g1 = gr[128 * hf + 1];
                __builtin_nontemporal_store((f32x4){x[8 * hf] * rs * g0[0], x[8 * hf + 1] * rs * g0[1], x[8 * hf + 2] * rs * g0[2], x[8 * hf + 3] * rs * g0[3]}, o + 128 * hf);
                __builtin_nontemporal_store((f32x4){x[8 * hf + 4] * rs * g1[0], x[8 * hf + 5] * rs * g1[1], x[8 * hf + 6] * rs * g1[2], x[8 * hf + 7] * rs * g1[3]}, o + 128 * hf + 1); } }
    }
}

constexpr int RTAB_OFF = 131072;
__device__ __forceinline__ void rstd_tables(const float* SSQ, const pg8::StaticOrder& S, LAS unsigned char* lds, int tid) {
    LAS float* tab = (LAS float*)(lds + RTAB_OFF); pg8::Unit u;
    const int r = tid & 255, sel = tid >> 8;
    for (int i0 = 0; i0 < 6; i0 += 2) {
        if (S.next(i0 + sel, u)) { const f32x4* p = (const f32x4*)(SSQ + (size_t)(u.pm * 256 + r) * 32); float s = 0.f;
#pragma unroll
            for (int k = 0; k < 8; ++k) { const f32x4 v = p[k]; s += (v[0] + v[1]) + (v[2] + v[3]); }
            tab[(i0 + sel) * 256 + r] = __builtin_amdgcn_rsqf(s * (1.0f / 1024.0f) + 1e-6f); }
    }
    __syncthreads();
}
__global__ void __launch_bounds__(NWAVES * 64, 2) fwd_megakernel(Args a) {
    extern __shared__ __attribute__((aligned(16))) unsigned char lds_raw[];
    cg::grid_group grid = cg::this_grid();
    LAS unsigned char* lds = (LAS unsigned char*)lds_raw;
    const int G = (int)gridDim.x, bx = (int)blockIdx.x;
    const int wave_s = __builtin_amdgcn_readfirstlane((int)threadIdx.x >> 6);
    { volatile LAS unsigned* misc = (volatile LAS unsigned*)(lds + MISC_OFF); if (threadIdx.x < 32) misc[threadIdx.x] = 0u; }
    __syncthreads();
    if (bx == 0) { unsigned* bw = (unsigned*)(KA(ws) + WS_BAR); for (int i = threadIdx.x; i < XCD_BAR_WORDS; i += NWAVES * 64) __hip_atomic_store(bw + i, 0u, __ATOMIC_RELAXED, __HIP_MEMORY_SCOPE_AGENT); }
#ifdef PROBE_TS
    int nst = 1; unsigned long long* tsb = (unsigned long long*)(KA(ws) + MiB);
    if (bx == 0 && threadIdx.x == 0) tsb[0] = __builtin_amdgcn_s_memrealtime();
#define GSYNC() do { xcd_barrier(xbar, wave_s == 0 && fresh_lane() == 0); if (bx == 0 && threadIdx.x == 0) tsb[nst] = __builtin_amdgcn_s_memrealtime(); ++nst; } while (0)
#define GSYNC0() do { grid.sync(); if (bx == 0 && threadIdx.x == 0) tsb[nst] = __builtin_amdgcn_s_memrealtime(); ++nst; } while (0)
#else
#define GSYNC() xcd_barrier(xbar, wave_s == 0 && fresh_lane() == 0)
#define GSYNC0() grid.sync()
#endif
#define TLW int lane_ = fresh_lane(); asm volatile("" : "+v"(lane_)); const int lane = lane_, wave = wave_s, tid = wave_s * 64 + lane_; (void)tid; (void)lane; (void)wave;
#define PHASE_VARS \
    unsigned char* ws = KA(ws); unsigned char* sc = ws + WS_SCR; bf16* XN = (bf16*)(ws + WS_XN); float* SSQ = (float*)(ws + WS_SSQ); float* X = KA(out); (void)sc; (void)XN; (void)SSQ; (void)X;


#ifndef NO_PRO
    { TLW prologue(lds, tid, lane, wave); }
#endif

    GSYNC0();
    XcdBarrier xbar = xcd_barrier_post((unsigned*)(KA(ws) + WS_BAR), (volatile LAS unsigned*)(lds + MISC_OFF) + 8);

    for (int layer = 0; layer < 4; ++layer) {
        const int kind = layer % 3;
        PHASE_VARS
        if (kind == 0) {
            const int li = layer / 3; const unsigned char* pb = ws + WS_S5P + (size_t)li * MiB;
            bf16* Z = (bf16*)(sc + SC_Z); f32x2* SLOC = (f32x2*)(sc + SC_SLOC); f32x2* CAR = (f32x2*)(sc + SC_CAR);

#ifndef NO_S5A
            { TLW s5_phaseA(pb, XN, SSQ, SLOC, lds, tid, lane, wave); }
#endif

            GSYNC();

#ifndef NO_S5B
            { TLW s5_phaseB(pb, SLOC, CAR, lds, tid); }
#endif

            GSYNC();

#ifndef NO_S5C
            { TLW s5_phaseC(pb, XN, SSQ, CAR, KA(s5_d) + li * D, KA(norm_mix) + layer * D, Z, lds, tid, lane, wave); }
#endif

            GSYNC();
            { pg8::Gemm g{Z, (const bf16*)(ws + WS_WGLU) + (size_t)li * 2048 * 1024, M, 2048, D}; pg8::StaticOrder S; S.init(M, 2048, G, bx);
              pg8::EpiGluResid E{(layer == 0) ? KA(x) : nullptr, XN, SSQ};

#ifndef NO_GGLU
              pg8::gemm_phase<pg8::EpiGluResid, pg8::StaticOrder, true, true>(lds, g, S, E, wave_s);
#endif
 }

            GSYNC();
        } else if (kind == 1) {
            bf16 *Qb = (bf16*)(sc + SC_GQ), *Kb = (bf16*)(sc + SC_GK), *Vb = (bf16*)(sc + SC_GV), *SGb = (bf16*)(sc + SC_GSG), *UPD = (bf16*)(sc + SC_GUPD), *O2 = (bf16*)(sc + SC_GO2);
            float *LA = (float*)(sc + SC_GLA), *DEC = (float*)(sc + SC_GDEC);
            { pg8::Gemm g{XN, (const bf16*)(ws + WS_WIN), M, 3584, D}; pg8::StaticOrder S; S.init(M, 3584, G, bx);
              { TLW rstd_tables(SSQ, S, lds, tid); }
              pg8::EpiGlaIn E{Qb, LA, KA(gla_b_a), (const LAS float*)(lds + RTAB_OFF)};

#ifndef NO_GIN
              pg8::gemm_phase<pg8::EpiGlaIn, pg8::StaticOrder, true, true>(lds, g, S, E, wave_s);
#endif
 }

            GSYNC();

#ifndef NO_G1
            { TLW gla_g1(Kb, Vb, LA, UPD, DEC, lds, tid, lane, wave); }
#endif

            GSYNC();

#ifndef NO_G2
            { TLW gla_g2(UPD, DEC, lds, tid); }
#endif

            GSYNC();

#ifndef NO_G3
            { TLW gla_g3(Qb, UPD, SGb, KA(gla_norm), O2, lds, tid, lane, wave); }
#endif

            GSYNC();
        } else {
            bf16 *Qb = (bf16*)(sc + SC_DQ), *Kb = (bf16*)(sc + SC_DK), *Vb = (bf16*)(sc + SC_DV), *Ob = (bf16*)(sc + SC_DO), *OC = (bf16*)(sc + SC_DOC);
            { pg8::Gemm g{XN, (const bf16*)(ws + WS_WQKV), M, 3072, D}; pg8::StaticOrder S; S.init(M, 3072, G, bx);
              { TLW rstd_tables(SSQ, S, lds, tid); }
              pg8::EpiDiffQkv E{Qb, KA(pos), (const LAS float*)(lds + RTAB_OFF)};

#ifndef NO_GQKV
              pg8::gemm_phase<pg8::EpiDiffQkv, pg8::StaticOrder, true, true>(lds, g, S, E, wave_s);
#endif
 }

            GSYNC();
            { const attn_body::AttnTensors AT{(const attn_body::bf16*)Qb, (const attn_body::bf16*)Kb, (const attn_body::bf16*)Vb, (attn_body::bf16*)Ob};
              const attn_body::StaticOrder S(G, bx);

#ifndef NO_ATTN
              attn_body::attn_phase<attn_body::StaticOrder>((char*)lds_raw, AT, S, wave_s);
#endif
 }

            GSYNC();

#ifndef NO_COMB
            { TLW diff_combine(Ob, OC, lane, wave); }
#endif

            GSYNC();
        }
        for (int st = (kind == 0 ? 1 : 0); st < 3; ++st) {
            if (st == 1) {
                pg8::Gemm g{XN, (const bf16*)(ws + WS_WGU) + (size_t)layer * 5632 * 1024, M, 5632, D}; pg8::StaticOrder S; S.init(M, 5632, G, bx);
                { TLW rstd_tables(SSQ, S, lds, tid); }
                pg8::EpiSwiglu E{(bf16*)(sc + SC_H), (const LAS float*)(lds + RTAB_OFF)};

#ifndef NO_GUP
                pg8::gemm_phase<pg8::EpiSwiglu, pg8::StaticOrder, true, true>(lds, g, S, E, wave_s);
#endif
                { const int nfull = (64 * 22) % G;
                  if (layer < 3 && nfull > 0 && bx >= nfull) { TLW convert_set(layer + 1, (bx - nfull) * NWAVES + wave, (G - nfull) * NWAVES, bx - nfull, G - nfull, lds, tid, lane, wave); }
                  else if (layer < 3 && nfull == 0) { TLW convert_set(layer + 1, bx * NWAVES + wave, G * NWAVES, bx, G, lds, tid, lane, wave); } }

            } else {
                const bf16* A; const bf16* Bt; int K;
                if (st == 0) { A = (kind == 1) ? (const bf16*)(sc + SC_GO2) : (const bf16*)(sc + SC_DOC); Bt = (kind == 1) ? (const bf16*)(ws + WS_WOG) : (const bf16*)(ws + WS_WOD); K = D; }
                else { A = (const bf16*)(sc + SC_H); Bt = (const bf16*)(ws + WS_WD) + (size_t)layer * 1024 * 2816; K = FF; }
                pg8::Gemm g{A, Bt, M, D, K}; pg8::StaticOrder S; S.init(M, D, G, bx);
                pg8::EpiResid E{XN, SSQ};

#ifndef NO_GRES
                pg8::gemm_phase<pg8::EpiResid, pg8::StaticOrder, true, true>(lds, g, S, E, wave_s);
#endif

            }
            GSYNC();
        }
    }

#ifndef NO_FIN
    { TLW final_norm((const bf16*)(KA(ws) + WS_XN), KA(out), KA(norm_final), lane, wave); }
#endif
#ifdef PROBE_TS
    GSYNC();
#ifdef PROBE_SYNCS
    for (int i = 0; i < 10; ++i) GSYNC();
#endif
    { const float T1 = ((float)(tsb[PROBE_A1] - tsb[PROBE_A0]) * 0.01f - PROBE_OFF) * PROBE_SCALE;
      if (bx == 0 && threadIdx.x == 0) KA(out)[0] = T1; }
#endif

}

extern "C" void kernel_launch(void* const* d_in, const int* in_sizes, int n_in, void* d_out, int out_size, void* d_ws, size_t ws_size, hipStream_t stream) {
    static int grid = 0;
    if (grid == 0) {
        if (n_in != 28 || in_sizes[0] != M * D || out_size != M * D || ws_size < WS_END) { fprintf(stderr, "kernel_launch: unexpected shapes (n_in %d, in0 %d, out %d, ws %zu need %zu)\n", n_in, n_in > 0 ? in_sizes[0] : -1, out_size, ws_size, (size_t)WS_END); grid = -1; return; }
        int dev = 0, cus = 0, per_cu = 0;
        hipGetDevice(&dev); hipDeviceGetAttribute(&cus, hipDeviceAttributeMultiprocessorCount, dev);
        if (hipFuncSetAttribute((const void*)fwd_megakernel, hipFuncAttributeMaxDynamicSharedMemorySize, LDS_BYTES) != hipSuccess) { fprintf(stderr, "kernel_launch: hipFuncSetAttribute failed\n"); grid = -1; return; }
        hipOccupancyMaxActiveBlocksPerMultiprocessor(&per_cu, (const void*)fwd_megakernel, NWAVES * 64, LDS_BYTES);
        if (per_cu < 1) { fprintf(stderr, "kernel_launch: occupancy query says %d blocks per CU\n", per_cu); per_cu = 1; }
        (void)hipGetLastError();
        grid = cus * 1;
    }
    if (grid < 0) return;
    Args a{};
    a.x = (const float*)d_in[0]; a.pos = (const int*)d_in[1]; a.norm_mix = (const float*)d_in[2]; a.norm_ffn = (const float*)d_in[3]; a.norm_final = (const float*)d_in[4];
    a.s5_lam_re = (const float*)d_in[5]; a.s5_lam_im = (const float*)d_in[6]; a.s5_log_dt = (const float*)d_in[7]; a.s5_b_re = (const float*)d_in[8]; a.s5_b_im = (const float*)d_in[9];
    a.s5_c_re = (const float*)d_in[10]; a.s5_c_im = (const float*)d_in[11]; a.s5_d = (const float*)d_in[12]; a.s5_w_glu = (const float*)d_in[13];
    a.gla_w_in = (const float*)d_in[14]; a.gla_w_a2 = (const float*)d_in[15]; a.gla_b_a = (const float*)d_in[16]; a.gla_norm = (const float*)d_in[17]; a.gla_w_o = (const float*)d_in[18];
    a.diff_w_qkv = (const float*)d_in[19]; a.diff_lq1 = (const float*)d_in[20]; a.diff_lk1 = (const float*)d_in[21]; a.diff_lq2 = (const float*)d_in[22]; a.diff_lk2 = (const float*)d_in[23];
    a.diff_subln = (const float*)d_in[24]; a.diff_w_o = (const float*)d_in[25]; a.ffn_w_gu = (const float*)d_in[26]; a.ffn_w_d = (const float*)d_in[27];
    a.out = (float*)d_out; a.ws = (unsigned char*)d_ws;
    void* args[] = {&a};
    hipError_t e = hipLaunchCooperativeKernel((const void*)fwd_megakernel, dim3(grid), dim3(NWAVES * 64), args, LDS_BYTES, stream);
    if (e != hipSuccess) fprintf(stderr, "cooperative launch failed: %s (grid %d)\n", hipGetErrorString(e), grid);
}
```

```cpp
#include <hip/hip_runtime.h>
#include <hip/hip_cooperative_groups.h>
#include <hip/hip_bf16.h>
#include <cstdio>
#include <cstdint>
#include <cstddef>
#include <cmath>
namespace cg = cooperative_groups;
__device__ __forceinline__ int fresh_lane() { int l; asm volatile("v_mbcnt_lo_u32_b32 %0, -1, 0\n\tv_mbcnt_hi_u32_b32 %0, -1, %0" : "=v"(l)); return l; }
__device__ __forceinline__ float shx(float v, int m) {
    int l = fresh_lane(); asm volatile("" : "+v"(l));
    return __builtin_bit_cast(float, __builtin_amdgcn_ds_bpermute((l ^ m) << 2, __builtin_bit_cast(int, v)));
}
namespace pg8 {
#define PG8_LAS __attribute__((address_space(3)))
typedef unsigned short bf16_t;
typedef short bf16x8 __attribute__((ext_vector_type(8)));
typedef float f32x4 __attribute__((ext_vector_type(4)));
typedef unsigned u32x4 __attribute__((ext_vector_type(4)));
constexpr int BM = 256, BK = 64, HALF = 128, HTB = HALF * BK * 2  , STAGE_BYTES = 8 * HTB, NXCD = 8, WGM = 8;

__host__ __device__ __forceinline__ int lds_byte(int r, int c) { const int st = (r >> 4) * 2 + (c >> 5), rr = r & 15, cc = c & 31, ob = rr * 64 + cc * 2; return st * 1024 + (ob ^ (((ob >> 9) & 1) << 5)); }
__host__ __device__ __forceinline__ void stage_rc(int b, int& R, int& C) { const int st = b / 1024, sb = b % 1024, swz = sb ^ (((sb >> 9) & 1) << 5); R = (st >> 1) * 16 + swz / 64; C = (st & 1) * 32 + (swz % 64) / 2; }
__host__ __device__ __forceinline__ int perm32(int rho) { const int n = rho >> 4, i = rho & 15; return 8 * (i >> 2) + 4 * n + (i & 3); }

struct Unit { int pm, pn; };
struct Gemm { const bf16_t* A; const bf16_t* Bt; int M, N, K; };

struct StaticOrder {
    int nM, nN, nwg, G, c;
    __host__ __device__ void init(int M, int N, int G_, int c_) { nM = M / BM; nN = N / BM; nwg = nM * nN; G = G_; c = c_; }
    __host__ __device__ bool next(int i, Unit& u) const {
        const long L = (long)i * G + c; if (L >= nwg) return false;
        int wgid = (int)L; { const int q = nwg / NXCD, r = nwg % NXCD, xcd = wgid % NXCD, off = wgid / NXCD; wgid = (xcd < r ? xcd * (q + 1) : r * (q + 1) + (xcd - r) * q) + off; }
        const int nig = WGM * nN, gid = wgid / nig, fm = gid * WGM, gsz = (nM - fm) < WGM ? (nM - fm) : WGM;
        u.pm = fm + ((wgid % nig) % gsz); u.pn = (wgid % nig) / gsz; return true;
    }
    __device__ __forceinline__ void a_ready(const Unit&) const {}
    __device__ __forceinline__ void done(const Unit&) const {}
};
__device__ __forceinline__ unsigned cvt_pk_bf16(float lo, float hi) { unsigned r; asm volatile("v_cvt_pk_bf16_f32 %0, %1, %2" : "=v"(r) : "v"(lo), "v"(hi)); return r; }
typedef float f32x2 __attribute__((ext_vector_type(2)));
template <class Epi, class Sched, bool ALIGN_EPI = false, bool SP2 = false>
__device__ __forceinline__ void gemm_phase(PG8_LAS unsigned char* lds, const Gemm g, const Sched& S, const Epi& E, const int wave_s) {
    int tid_ = wave_s * 64 + fresh_lane(); asm volatile("" : "+v"(tid_));
    const int tid = tid_, wid = __builtin_amdgcn_readfirstlane(tid >> 6), lane = tid & 63, wr = wid >> 2, wc = wid & 3, fr = lane & 15, fq = lane >> 4;
    const int K = g.K, nt = K / BK;
    unsigned voffA[2], voffB[2];
#pragma unroll
    for (int i = 0; i < 2; ++i) { int R, C; stage_rc(tid * 16 + i * 8192, R, C); const int Rb = Epi::PERM ? ((R & ~31) + perm32(R & 31)) : R;
        voffA[i] = (unsigned)(R * K + C) * 2u; voffB[i] = (unsigned)(Rb * K + C) * 2u; }
    const size_t kstep = (size_t)(BK * 2);
    const size_t hstep = (size_t)HALF * K * 2;
    const size_t tstep = 2 * hstep;
    const unsigned ldsw = (unsigned)wid * 1024u;
    const int aoff = lds_byte(wr * 64 + fr, fq * 8), boff = lds_byte(wc * 32 + fr, fq * 8);
#define PG8_SA(b, h) (((b) * 2 + (h)) * HTB)
#define PG8_SB(b, h) ((4 + (b) * 2 + (h)) * HTB)
#define PG8_STAGE(bufoff, gbase, voff) do { _Pragma("unroll") for (int _i = 0; _i < 2; ++_i) \
        __builtin_amdgcn_global_load_lds((const unsigned*)((const char*)(gbase) + (voff)[_i]), (PG8_LAS unsigned*)(lds + (bufoff) + ldsw + _i * 8192), 16, 0, 0); } while (0)
#define PG8_LDA(dst, b, h) do { _Pragma("unroll") for (int m = 0; m < 4; ++m) _Pragma("unroll") for (int k = 0; k < 2; ++k) dst[m][k] = *(const PG8_LAS bf16x8*)(lds + PG8_SA(b, h) + aoff + m * 2048 + k * 1024); } while (0)
#define PG8_LDB(dst, b, h) do { _Pragma("unroll") for (int n = 0; n < 2; ++n) _Pragma("unroll") for (int k = 0; k < 2; ++k) dst[n][k] = *(const PG8_LAS bf16x8*)(lds + PG8_SB(b, h) + boff + n * 2048 + k * 1024); } while (0)
#define PG8_MMA(ai, bj, At, Bt) do { __builtin_amdgcn_s_setprio(1); _Pragma("unroll") for (int m = 0; m < 4; ++m) _Pragma("unroll") for (int n = 0; n < 2; ++n) _Pragma("unroll") for (int k = 0; k < 2; ++k) \
        acc[ai][bj][m][n] = __builtin_amdgcn_mfma_f32_16x16x32_bf16(Bt[n][k], At[m][k], acc[ai][bj][m][n], 0, 0, 0); __builtin_amdgcn_s_setprio(0); } while (0)
#define PG8_WAIT_V(n) asm volatile("s_waitcnt vmcnt(" #n ")" ::: "memory")
#define PG8_WAIT_L(n) asm volatile("s_waitcnt lgkmcnt(" #n ")" ::: "memory")
#define PG8_BAR __builtin_amdgcn_s_barrier()
#define PG8_SCHED __builtin_amdgcn_sched_barrier(0)
    Unit cur, nxt; int ui = 0;
    if (!S.next(0, cur)) return;
    f32x4 acc[2][2][4][2];
#pragma unroll
    for (int a = 0; a < 2; ++a)
#pragma unroll
        for (int b = 0; b < 2; ++b)
#pragma unroll
            for (int m = 0; m < 4; ++m)
#pragma unroll
                for (int n = 0; n < 2; ++n) acc[a][b][m][n] = (f32x4){0.f, 0.f, 0.f, 0.f};
    bf16x8 At[4][2], B0[2][2], B1[2][2];
    const char* cA = (const char*)g.A + (size_t)cur.pm * tstep; const char* cB = (const char*)g.Bt + (size_t)cur.pn * tstep;
    S.a_ready(cur);
    if constexpr (SP2) {
        PG8_STAGE(PG8_SB(0, 0), cB, voffB); PG8_STAGE(PG8_SB(0, 1), cB + hstep, voffB); PG8_STAGE(PG8_SA(0, 0), cA, voffA); PG8_STAGE(PG8_SA(0, 1), cA + hstep, voffA);
        if (wr == 1) PG8_BAR;
        PG8_WAIT_V(2); PG8_BAR;
        PG8_STAGE(PG8_SB(1, 0), cB + kstep, voffB); PG8_STAGE(PG8_SA(1, 0), cA + kstep, voffA); PG8_STAGE(PG8_SB(1, 1), cB + hstep + kstep, voffB);
        PG8_WAIT_V(6); PG8_BAR;
    } else {
        PG8_STAGE(PG8_SB(0, 0), cB, voffB); PG8_STAGE(PG8_SA(0, 0), cA, voffA); PG8_STAGE(PG8_SB(0, 1), cB + hstep, voffB); PG8_STAGE(PG8_SA(0, 1), cA + hstep, voffA);
        if (wr == 1) PG8_BAR;
        PG8_WAIT_V(4); PG8_BAR;
        PG8_STAGE(PG8_SB(1, 0), cB + kstep, voffB); PG8_STAGE(PG8_SA(1, 0), cA + kstep, voffA); PG8_STAGE(PG8_SB(1, 1), cB + hstep + kstep, voffB);
        PG8_WAIT_V(6); PG8_BAR;
    }
    for (;;) {
        const bool has_next = S.next(ui + 1, nxt);
        const char* nA = has_next ? (const char*)g.A + (size_t)nxt.pm * tstep : cA; const char* nB = has_next ? (const char*)g.Bt + (size_t)nxt.pn * tstep : cB;
        for (int t = 0; t < nt; t += 2) {
            const bool last = (t == nt - 2);
            const char* a1 = cA + (size_t)(t + 1) * kstep;
            const char* a2 = last ? nA : cA + (size_t)(t + 2) * kstep; const char* b2 = last ? nB : cB + (size_t)(t + 2) * kstep;
            const char* a3 = a2 + kstep; const char* b3 = b2 + kstep;
            if (last && has_next) S.a_ready(nxt);
            if constexpr (SP2) {
            PG8_LDB(B0, 0, 0); PG8_LDB(B1, 0, 1); PG8_SCHED; PG8_LDA(At, 0, 0); PG8_STAGE(PG8_SA(1, 1), a1 + hstep, voffA);
            PG8_WAIT_V(8); PG8_WAIT_L(0); PG8_BAR; PG8_MMA(0, 0, At, B0); PG8_MMA(0, 1, At, B1); PG8_BAR; PG8_SCHED;
            PG8_LDA(At, 0, 1); PG8_STAGE(PG8_SB(0, 0), b2, voffB); PG8_STAGE(PG8_SB(0, 1), b2 + hstep, voffB); PG8_STAGE(PG8_SA(0, 0), a2, voffA);
            PG8_WAIT_V(8); PG8_WAIT_L(0); PG8_BAR; PG8_MMA(1, 0, At, B0); PG8_MMA(1, 1, At, B1); PG8_BAR; PG8_SCHED;
            PG8_LDB(B0, 1, 0); PG8_LDB(B1, 1, 1); PG8_SCHED; PG8_LDA(At, 1, 0); PG8_STAGE(PG8_SA(0, 1), a2 + hstep, voffA);
            PG8_WAIT_V(8); PG8_WAIT_L(0); PG8_BAR; PG8_MMA(0, 0, At, B0); PG8_MMA(0, 1, At, B1); PG8_BAR; PG8_SCHED;
            PG8_LDA(At, 1, 1); PG8_STAGE(PG8_SB(1, 0), b3, voffB); PG8_STAGE(PG8_SB(1, 1), b3 + hstep, voffB); PG8_STAGE(PG8_SA(1, 0), a3, voffA);
            PG8_WAIT_V(8); PG8_WAIT_L(0); PG8_BAR; PG8_MMA(1, 0, At, B0); PG8_MMA(1, 1, At, B1); PG8_BAR; PG8_SCHED;
            } else {
            PG8_LDB(B0, 0, 0); PG8_SCHED; PG8_LDA(At, 0, 0); PG8_STAGE(PG8_SA(1, 1), a1 + hstep, voffA);
            PG8_WAIT_L(8); PG8_BAR; PG8_WAIT_L(0); PG8_MMA(0, 0, At, B0); PG8_BAR; PG8_SCHED;
            PG8_LDB(B1, 0, 1); PG8_STAGE(PG8_SB(0, 0), b2, voffB);
            PG8_BAR; PG8_WAIT_L(0); PG8_MMA(0, 1, At, B1); PG8_BAR;
            PG8_LDA(At, 0, 1); PG8_STAGE(PG8_SA(0, 0), a2, voffA);
            PG8_BAR; PG8_WAIT_L(0); PG8_MMA(1, 0, At, B0); PG8_BAR; PG8_SCHED;
            PG8_STAGE(PG8_SB(0, 1), b2 + hstep, voffB);
            PG8_WAIT_V(6); PG8_BAR; PG8_MMA(1, 1, At, B1); PG8_BAR;
            PG8_LDB(B0, 1, 0); PG8_SCHED; PG8_LDA(At, 1, 0); PG8_STAGE(PG8_SA(0, 1), a2 + hstep, voffA);
            PG8_WAIT_L(8); PG8_BAR; PG8_WAIT_L(0); PG8_MMA(0, 0, At, B0); PG8_BAR; PG8_SCHED;
            PG8_LDB(B1, 1, 1); PG8_STAGE(PG8_SB(1, 0), b3, voffB);
            PG8_BAR; PG8_WAIT_L(0); PG8_MMA(0, 1, At, B1); PG8_BAR;
            PG8_LDA(At, 1, 1); PG8_STAGE(PG8_SA(1, 0), a3, voffA);
            PG8_BAR; PG8_WAIT_L(0); PG8_MMA(1, 0, At, B0); PG8_BAR; PG8_SCHED;
            PG8_STAGE(PG8_SB(1, 1), b3 + hstep, voffB);
            PG8_WAIT_V(6); PG8_BAR; PG8_MMA(1, 1, At, B1); PG8_BAR;
            }
        }
        if constexpr (ALIGN_EPI) { if (wr == 0) PG8_BAR; }
        if constexpr (!Epi::AFTER_DRAIN) { E(acc, cur, wr, wc, fr, fq, ui); S.done(cur); }
        if (!has_next) break;
#pragma unroll
        for (int a = 0; a < 2; ++a)
#pragma unroll
            for (int b = 0; b < 2; ++b)
#pragma unroll
                for (int m = 0; m < 4; ++m)
#pragma unroll
                    for (int n = 0; n < 2; ++n) acc[a][b][m][n] = (f32x4){0.f, 0.f, 0.f, 0.f};
        cur = nxt; cA = nA; cB = nB; ++ui;
        if constexpr (ALIGN_EPI) { if (wr == 1) PG8_BAR; }
    }
    PG8_WAIT_V(0);
    if constexpr (!ALIGN_EPI) { if (wr == 0) PG8_BAR; }
    PG8_BAR;
    if constexpr (Epi::AFTER_DRAIN) { E.fused(acc, cur, wr, wc, fr, fq, lds, wid, lane); S.done(cur); }
#undef PG8_SA
#undef PG8_SB
#undef PG8_STAGE
#undef PG8_LDA
#undef PG8_LDB
#undef PG8_MMA
#undef PG8_WAIT_V
#undef PG8_WAIT_L
#undef PG8_BAR
#undef PG8_SCHED
}
}
namespace pg8 {
__device__ __forceinline__ float fast_sigmoid(float x) { return __builtin_amdgcn_rcpf(1.0f + __builtin_amdgcn_exp2f(-1.4426950408889634f * x)); }
__device__ __forceinline__ float row_rstd(const float* ssq, int row, int fq) {
    const f32x4* p = (const f32x4*)(ssq + (size_t)row * 32 + 8 * fq);
    const f32x4 a = p[0], b = p[1];
    float s = ((a[0] + a[1]) + (a[2] + a[3])) + ((b[0] + b[1]) + (b[2] + b[3]));
    s += shx(s, 16); s += shx(s, 32);
    return __builtin_amdgcn_rsqf(s * (1.0f / 1024.0f) + 1e-6f);
}
__device__ __forceinline__ u32x4 pack8(const f32x4 a, const f32x4 b) { u32x4 w; w.x = cvt_pk_bf16(a[0], a[1]); w.y = cvt_pk_bf16(a[2], a[3]); w.z = cvt_pk_bf16(b[0], b[1]); w.w = cvt_pk_bf16(b[2], b[3]); return w; }

__device__ __forceinline__ float bflo(unsigned w) { return __builtin_bit_cast(float, w << 16); }
__device__ __forceinline__ float bfhi(unsigned w) { return __builtin_bit_cast(float, w & 0xffff0000u); }
struct EpiResid {
    static constexpr bool PERM = true, AFTER_DRAIN = false;
    bf16_t* xb; float* ssq;
    __device__ __forceinline__ void operator()(const f32x4 (&acc)[2][2][4][2], const Unit& u, int wr, int wc, int fr, int fq, int ui) const {
        const int col0 = u.pn * BM + wc * 32 + 8 * fq;
#pragma unroll
        for (int ai = 0; ai < 2; ++ai)
#pragma unroll
            for (int m = 0; m < 4; ++m) {
                const int row = u.pm * BM + ai * HALF + wr * 64 + m * 16 + fr;
#pragma unroll
                for (int bj = 0; bj < 2; ++bj) {
                    const size_t off = (size_t)row * 1024 + col0 + bj * HALF;
                    const u32x4 xw = *(const u32x4*)(xb + off);
                    const f32x4 x0 = (f32x4){bflo(xw.x), bfhi(xw.x), bflo(xw.y), bfhi(xw.y)} + acc[ai][bj][m][0], x1 = (f32x4){bflo(xw.z), bfhi(xw.z), bflo(xw.w), bfhi(xw.w)} + acc[ai][bj][m][1];
                    float s = ((x0[0] * x0[0] + x0[1] * x0[1]) + (x0[2] * x0[2] + x0[3] * x0[3])) + ((x1[0] * x1[0] + x1[1] * x1[1]) + (x1[2] * x1[2] + x1[3] * x1[3]));
                    s += shx(s, 16); s += shx(s, 32);
                    if (fq == 0) ssq[(size_t)row * 32 + u.pn * 8 + bj * 4 + wc] = s;
                    *(u32x4*)(xb + off) = pack8(x0, x1);
                }
                if (m == 3) asm volatile("" ::: "memory");
            }
    }
};
struct EpiGluResid {
    static constexpr bool PERM = true, AFTER_DRAIN = false;
    const float* xin; bf16_t* xb; float* ssq;
    __device__ __forceinline__ void operator()(const f32x4 (&acc)[2][2][4][2], const Unit& u, int wr, int wc, int fr, int fq, int ui) const {
        const int col0 = u.pn * HALF + wc * 32 + 8 * fq;
#pragma unroll
        for (int ai = 0; ai < 2; ++ai)
#pragma unroll
            for (int m = 0; m < 4; ++m) {
                const int row = u.pm * BM + ai * HALF + wr * 64 + m * 16 + fr;
                const size_t off = (size_t)row * 1024 + col0;
                f32x4 x0, x1;
                if (xin) { x0 = *(const f32x4*)(xin + off); x1 = *(const f32x4*)(xin + off + 4); }
                else { const u32x4 xw = *(const u32x4*)(xb + off); x0 = (f32x4){bflo(xw.x), bfhi(xw.x), bflo(xw.y), bfhi(xw.y)}; x1 = (f32x4){bflo(xw.z), bfhi(xw.z), bflo(xw.w), bfhi(xw.w)}; }
#pragma unroll
                for (int j = 0; j < 4; ++j) { x0[j] += acc[ai][0][m][0][j] * fast_sigmoid(acc[ai][1][m][0][j]); x1[j] += acc[ai][0][m][1][j] * fast_sigmoid(acc[ai][1][m][1][j]); }
                float s = ((x0[0] * x0[0] + x0[1] * x0[1]) + (x0[2] * x0[2] + x0[3] * x0[3])) + ((x1[0] * x1[0] + x1[1] * x1[1]) + (x1[2] * x1[2] + x1[3] * x1[3]));
                s += shx(s, 16); s += shx(s, 32);
                if (fq == 0) ssq[(size_t)row * 32 + u.pn * 4 + wc] = s;
                *(u32x4*)(xb + off) = pack8(x0, x1);
                if (m == 3) asm volatile("" ::: "memory");
            }
    }
};
struct EpiSwiglu {
    static constexpr bool PERM = true, AFTER_DRAIN = false;
    bf16_t* H; const PG8_LAS float* rtab;
    __device__ __forceinline__ void operator()(const f32x4 (&acc)[2][2][4][2], const Unit& u, int wr, int wc, int fr, int fq, int ui) const {
        const int col0 = u.pn * HALF + wc * 32 + 8 * fq;
#pragma unroll
        for (int ai = 0; ai < 2; ++ai)
#pragma unroll
            for (int m = 0; m < 4; ++m) {
                const int row = u.pm * BM + ai * HALF + wr * 64 + m * 16 + fr;
                const float rs = rtab[ui * 256 + ai * HALF + wr * 64 + m * 16 + fr];
                f32x4 h0, h1;
#pragma unroll
                for (int j = 0; j < 4; ++j) { const float ga = acc[ai][0][m][0][j] * rs, gb = acc[ai][0][m][1][j] * rs;
                    h0[j] = ga * fast_sigmoid(ga) * (acc[ai][1][m][0][j] * rs); h1[j] = gb * fast_sigmoid(gb) * (acc[ai][1][m][1][j] * rs); }
                *(u32x4*)(H + (size_t)row * 2816 + col0) = pack8(h0, h1);
            }
    }
};
struct EpiGlaIn {
    static constexpr bool PERM = true, AFTER_DRAIN = false;
    bf16_t* Q; float* LA; const float* ba; const PG8_LAS float* rtab;
    __device__ __forceinline__ void operator()(const f32x4 (&acc)[2][2][4][2], const Unit& u, int wr, int wc, int fr, int fq, int ui) const {
        const int pn = u.pn; const int cw = wc * 32 + 8 * fq;
        const size_t eoff = (pn < 2) ? (size_t)0 : ((pn < 4) ? (size_t)8388608 : ((pn < 8) ? (size_t)16777216 : (size_t)33554432));
        const int ld = (pn < 4) ? 512 : 1024; const int c0 = ((pn < 4) ? (pn & 1) : (pn & 3)) * 256; const float sc = (pn < 2) ? 0.08838834764831845f : 1.0f;
        bf16_t* base = Q + eoff;
#pragma unroll
        for (int ai = 0; ai < 2; ++ai)
#pragma unroll
            for (int m = 0; m < 4; ++m) {
                const int row = u.pm * BM + ai * HALF + wr * 64 + m * 16 + fr;
                const float rs = rtab[ui * 256 + ai * HALF + wr * 64 + m * 16 + fr] * sc;
#pragma unroll
                for (int bj = 0; bj < 2; ++bj) {
                    f32x4 v0 = acc[ai][bj][m][0] * rs, v1 = acc[ai][bj][m][1] * rs;
                    if (pn >= 12) {
                        const int c = (pn - 12) * 256 + bj * HALF + cw;
                        const f32x4 b0 = *(const f32x4*)(ba + c), b1 = *(const f32x4*)(ba + c + 4);
#pragma unroll
                        for (int j = 0; j < 4; ++j) { const float z0 = v0[j] + b0[j], z1 = v1[j] + b1[j];
                            v0[j] = (fminf(z0, 0.f) - __logf(1.0f + __expf(-fabsf(z0)))) * 0.0625f; v1[j] = (fminf(z1, 0.f) - __logf(1.0f + __expf(-fabsf(z1)))) * 0.0625f; }
                        float* o = LA + (size_t)row * 512 + c; *(f32x4*)o = v0; *(f32x4*)(o + 4) = v1;
                    } else {
                        if (pn >= 8) {
#pragma unroll
                            for (int j = 0; j < 4; ++j) { v0[j] = v0[j] * fast_sigmoid(v0[j]); v1[j] = v1[j] * fast_sigmoid(v1[j]); } }
                        *(u32x4*)(base + (size_t)row * ld + c0 + bj * HALF + cw) = pack8(v0, v1);
                    }
                }
            }
    }
};
struct EpiDiffQkv {
    static constexpr bool PERM = true, AFTER_DRAIN = false;
    bf16_t* Q; const int* pos; const PG8_LAS float* rtab;
    __device__ __forceinline__ void operator()(const f32x4 (&acc)[2][2][4][2], const Unit& u, int wr, int wc, int fr, int fq, int ui) const {
        const int pn = u.pn; const int cw = wc * 32 + 8 * fq;
        bf16_t* base = Q + (size_t)(pn >> 2) * 16777216; const int c0 = (pn & 3) * 256;
        const float sc = pn < 4 ? 0.18033688011112042f : 1.0f;
        const bool rope = (pn < 8) && ((wc & 1) == 0);
        int prow[2][4];
        if (rope) {
#pragma unroll
            for (int ai = 0; ai < 2; ++ai)
#pragma unroll
                for (int m = 0; m < 4; ++m) prow[ai][m] = pos[u.pm * BM + ai * HALF + wr * 64 + m * 16 + fr]; }
        const double IF[8] = {0.15915494309189535, 0.03086376340470123, 0.005985185712713705, 0.001160663641240061, 0.00022507907903927653, 4.364795279280289e-05, 8.464330808241401e-06, 1.6414262627950345e-06};
#pragma unroll
        for (int ai = 0; ai < 2; ++ai)
#pragma unroll
            for (int m = 0; m < 4; ++m) {
                const int row = u.pm * BM + ai * HALF + wr * 64 + m * 16 + fr;
                const float rs = rtab[ui * 256 + ai * HALF + wr * 64 + m * 16 + fr] * sc;
                float cs[8], sn[8];
                if (rope) { const double p = (double)prow[ai][m];
#pragma unroll
                    for (int i = 0; i < 8; ++i) { const double r = p * IF[i]; const float f = (float)(r - __builtin_floor(r)); cs[i] = __builtin_amdgcn_cosf(f); sn[i] = __builtin_amdgcn_sinf(f); } }
#pragma unroll
                for (int bj = 0; bj < 2; ++bj) {
                    f32x4 v0 = acc[ai][bj][m][0] * rs, v1 = acc[ai][bj][m][1] * rs;
                    if (rope) {
#pragma unroll
                        for (int j = 0; j < 4; ++j) {
                            const float o0 = shx(v0[j], 16), o1 = shx(v1[j], 16);
                            if (fq == 0) { v0[j] = v0[j] * cs[j] - o0 * sn[j]; v1[j] = v1[j] * cs[4 + j] - o1 * sn[4 + j]; }
                            else if (fq == 1) { v0[j] = v0[j] * cs[j] + o0 * sn[j]; v1[j] = v1[j] * cs[4 + j] + o1 * sn[4 + j]; }
                        }
                    }
                    *(u32x4*)(base + (size_t)row * 1024 + c0 + bj * HALF + cw) = pack8(v0, v1);
                }
            }
    }
};
}
namespace attn_body {
using bf16=__hip_bfloat16;
using bf16x8=__attribute__((ext_vector_type(8)))short;
using s16x4=__attribute__((ext_vector_type(4)))short;
using f32x16=__attribute__((ext_vector_type(16)))float;
using u32x4=__attribute__((ext_vector_type(4)))unsigned;
constexpr int BATCH=1,NHEAD=16,SEQ=16384,D=64,DM=NHEAD*D;
constexpr int NW=8,QBLK=32,QB=QBLK*NW,KVBLK=64,NQB=SEQ/QB;
constexpr int ATTN_PITCH=DM, ATTN_UNIT_ROWS=QB;
__device__ __forceinline__ int crow(int r,int hi){return (r&3)+8*(r>>2)+4*hi;}
#define SBAR() __builtin_amdgcn_sched_barrier(0)
__device__ __forceinline__ void cmask(f32x16&p0,f32x16&p1,int jb,int qrel,int hi){
  const float NEG=-INFINITY; (void)hi;
  if(jb>(qrel>>6)){
  #pragma unroll
  for(int r=0;r<16;++r){p0[r]=NEG;p1[r]=NEG;}}
}

constexpr int NSLOT=3, SLOTB=8192;
constexpr int LDS_K=0, LDS_V=NSLOT*SLOTB, LDS_WS=3*NSLOT*SLOTB, LDS_OST=LDS_WS+NW*64*4, LDS_BYTES=LDS_OST+NW*4096;
constexpr float C2=0.125f*1.4426950408889634f;
__device__ __forceinline__ void glds16(const void*gsrc,unsigned lds_dst){unsigned keep;
  asm volatile("s_mov_b32 %0, m0\n\ts_mov_b32 m0, %2\n\ts_nop 0\n\tglobal_load_lds_dwordx4 %1, off\n\ts_mov_b32 m0, %0":"=&s"(keep):"v"(gsrc),"s"(lds_dst):"memory");}
__device__ __forceinline__ float max3f(float a,float b,float c){float r;asm("v_max3_f32 %0, %1, %2, %3":"=v"(r):"v"(a),"v"(b),"v"(c));return r;}
__device__ __forceinline__ float max2f(float a,float b){float r;asm("v_max_f32_e32 %0, %1, %2":"=v"(r):"v"(a),"v"(b));return r;}
__device__ __forceinline__ float fadd_s(float a,float b){float r;asm("v_add_f32_e32 %0, %1, %2":"=v"(r):"v"(a),"v"(b));return r;}
__device__ __forceinline__ float fsub_s(float a,float b){float r;asm("v_sub_f32_e32 %0, %1, %2":"=v"(r):"v"(a),"v"(b));return r;}
typedef float f32x2_t __attribute__((ext_vector_type(2))); typedef __bf16 bf16x2_t __attribute__((ext_vector_type(2)));
__device__ __forceinline__ unsigned cvtpk_s(float lo,float hi){f32x2_t v={lo,hi};bf16x2_t b=__builtin_convertvector(v,bf16x2_t);return __builtin_bit_cast(unsigned,b);}
#define WAIT_BAR(N) asm volatile("s_waitcnt vmcnt(" #N ") lgkmcnt(0)\n\ts_barrier":::"memory")

__device__ __forceinline__ void qkt(f32x16&p0,f32x16&p1,const char*Kslot,const bf16x8*qr,const f32x16&negm,int r32,int hi){
  const char*kb=Kslot+hi*1024+r32*16;
  #pragma unroll
  for(int d0=0;d0<4;++d0){
    const bf16x8 b0=*reinterpret_cast<const bf16x8*>(kb+d0*2048);
    const bf16x8 b1=*reinterpret_cast<const bf16x8*>(kb+d0*2048+512);
    if(d0==0){p0=__builtin_amdgcn_mfma_f32_32x32x16_bf16(b0,qr[0],negm,0,0,0);p1=__builtin_amdgcn_mfma_f32_32x32x16_bf16(b1,qr[0],negm,0,0,0);}
    else{p0=__builtin_amdgcn_mfma_f32_32x32x16_bf16(b0,qr[d0],p0,0,0,0);p1=__builtin_amdgcn_mfma_f32_32x32x16_bf16(b1,qr[d0],p1,0,0,0);}}
}
typedef __attribute__((address_space(3))) const char* lds_cptr;
typedef short v4i16_t __attribute__((ext_vector_type(4)));
__device__ __forceinline__ void kload8(bf16x8*kf,lds_cptr kp){
  kf[0]=*(const __attribute__((address_space(3))) bf16x8*)(kp);      kf[1]=*(const __attribute__((address_space(3))) bf16x8*)(kp+512);
  kf[2]=*(const __attribute__((address_space(3))) bf16x8*)(kp+2048); kf[3]=*(const __attribute__((address_space(3))) bf16x8*)(kp+2560);
  kf[4]=*(const __attribute__((address_space(3))) bf16x8*)(kp+4096); kf[5]=*(const __attribute__((address_space(3))) bf16x8*)(kp+4608);
  kf[6]=*(const __attribute__((address_space(3))) bf16x8*)(kp+6144); kf[7]=*(const __attribute__((address_space(3))) bf16x8*)(kp+6656);
}
__device__ __forceinline__ void kload2(bf16x8*kf,lds_cptr kp,int j){ kf[2*j]=*(const __attribute__((address_space(3))) bf16x8*)(kp+j*2048); kf[2*j+1]=*(const __attribute__((address_space(3))) bf16x8*)(kp+j*2048+512); }
__device__ __forceinline__ s16x4 vtr(lds_cptr p){ return __builtin_bit_cast(s16x4,__builtin_amdgcn_ds_read_tr16_b64_v4i16((__attribute__((address_space(3))) v4i16_t*)p)); }
__device__ __forceinline__ float rowmax(const f32x16&p0,const f32x16&p1){
  float a=max3f(p0[0],p0[1],p1[0]),b=max3f(p0[2],p0[3],p1[1]);a=max3f(a,p1[2],p1[3]);
  #pragma unroll
  for(int r=4;r<16;r+=4){a=max3f(a,p0[r],p0[r+1]);b=max3f(b,p0[r+2],p0[r+3]);a=max3f(a,p1[r],p1[r+1]);b=max3f(b,p1[r+2],p1[r+3]);}
  const float m=max2f(a,b);
  auto rr=__builtin_amdgcn_permlane32_swap(__float_as_uint(m),__float_as_uint(m),false,false);
  return max2f(__uint_as_float(rr[0]),__uint_as_float(rr[1]));
}
__device__ __forceinline__ void pv(f32x16*o,int vb,bf16x8 pa0,bf16x8 pa1,bf16x8 pa2,bf16x8 pa3){
  #pragma unroll
  for(int d0=0;d0<2;++d0){s16x4 lo[4],hi[4];
    #pragma unroll
    for(int ks=0;ks<4;++ks){
      asm volatile("ds_read_b64_tr_b16 %0,%1 offset:%c2":"=&v"(lo[ks]):"v"(vb),"i"(d0*4096+ks*1024):"memory");
      asm volatile("ds_read_b64_tr_b16 %0,%1 offset:%c2":"=&v"(hi[ks]):"v"(vb),"i"(d0*4096+ks*1024+512):"memory");}
    asm volatile("s_waitcnt lgkmcnt(0)":::"memory");SBAR();
    #define PK(k) (bf16x8){lo[k][0],lo[k][1],lo[k][2],lo[k][3],hi[k][0],hi[k][1],hi[k][2],hi[k][3]}
    o[d0]=__builtin_amdgcn_mfma_f32_32x32x16_bf16(pa0,PK(0),o[d0],0,0,0);
    o[d0]=__builtin_amdgcn_mfma_f32_32x32x16_bf16(pa1,PK(1),o[d0],0,0,0);
    o[d0]=__builtin_amdgcn_mfma_f32_32x32x16_bf16(pa2,PK(2),o[d0],0,0,0);
    o[d0]=__builtin_amdgcn_mfma_f32_32x32x16_bf16(pa3,PK(3),o[d0],0,0,0);
    #undef PK
  }
}

#ifndef ATTN_STORE16
#define ATTN_STORE16(p,v) (*(u32x4*)(p)=(v))
#endif
template<int THRL> __device__ __forceinline__ void attn_unit(int qb,const bf16*Qh,const bf16*__restrict__ Kh,const bf16*__restrict__ Vh,bf16*Oh,int opitch,char*shm,const int wave_s){
  int tid_=wave_s*64+fresh_lane(); asm volatile("":"+v"(tid_)); const int tid=tid_,lane=tid&63,r32=lane&31,hi=lane>>5; const int wid=__builtin_amdgcn_readfirstlane(tid>>6);
  const int q0=qb*QB;
  const bf16*Qw=Qh+(long)(q0+wid*QBLK)*DM;
  const unsigned lds0=(unsigned)(uintptr_t)shm;
  float*wsf=(float*)(shm+LDS_WS)+wid*64;
  const bf16*ksrc=Kh+(long)lane*DM+wid*8;
  const bf16*vsrc=Vh+(long)(16*(wid&3)+(lane>>2))*DM+(wid>>2)*32+(lane&3)*8;
  const unsigned kdst=lds0+LDS_K+wid*1024, vdst=lds0+LDS_V+wid*1024;
  #define DMA_K(t,slot) glds16(ksrc+(long)(t)*KVBLK*DM,(unsigned)__builtin_amdgcn_readfirstlane(kdst+(slot)))
  #define DMA_V(t,slot) do{ glds16(vsrc+(long)(t)*KVBLK*DM,(unsigned)__builtin_amdgcn_readfirstlane(vdst+2*(slot))); glds16(vsrc+(long)(t)*KVBLK*DM+64,(unsigned)__builtin_amdgcn_readfirstlane(vdst+2*(slot)+8192)); }while(0)
  const int vb0=(int)(lds0+LDS_V)+((lane>>4)&1)*32+(lane&3)*8+(4*hi+((lane&15)>>2))*64;
  const char*Kbase=shm+LDS_K; bf16x8 kf[8];
  const lds_cptr shm3=(lds_cptr)shm; const lds_cptr kp0=shm3+LDS_K+hi*1024+r32*16; const lds_cptr vp0=shm3+LDS_V+((lane>>4)&1)*32+(lane&3)*8+(4*hi+((lane&15)>>2))*64;
  const int NT=(q0+QB)/KVBLK;
  DMA_K(0,0);DMA_V(0,0);DMA_K(1,SLOTB);
  bf16x8 qr[4];
  #pragma unroll
  for(int d0=0;d0<4;++d0)qr[d0]=*reinterpret_cast<const bf16x8*>(&Qw[(long)r32*DM+d0*16+hi*8]);
  float mhat=0.f,l_reg=0.f;f32x16 o[2];o[0]=f32x16{};o[1]=f32x16{};f32x16 o2[2];o2[0]=f32x16{};o2[1]=f32x16{};const f32x16 ZC=f32x16{};
  const int qrel=wid*QBLK+r32;
  #define CMASK(P0,P1,t) do{int jb_=(t)-(NT-4); if(jb_>=0)cmask(P0,P1,jb_,qrel,hi);}while(0)
  bool resc=false;
  #define START(P0,P1) do{ const float rm=rowmax(P0,P1); resc=false; \
    { const float dl=rm; mhat=fadd_s(mhat,dl); \
      _Pragma("unroll") for(int r=0;r<16;++r){P0[r]=fsub_s(P0[r],dl);P1[r]=fsub_s(P1[r],dl);} \
      } \
    _Pragma("unroll") for(int r=0;r<16;++r)P0[r]=__builtin_amdgcn_exp2f(P0[r]); }while(0)
  #define RESC() do{ if(resc){ asm volatile("s_waitcnt lgkmcnt(0)":::"memory"); \
      _Pragma("unroll") for(int d_=0;d_<2;++d_) _Pragma("unroll") for(int r=0;r<16;++r){const float f_=wsf[crow(r,hi)];o[d_][r]*=f_;o2[d_][r]*=f_;} } }while(0)
  f32x16 pA0,pA1,pB0,pB1;
  int sl_prev=0,sl_cur=0,sl_next=SLOTB;
  #define ROT() do{sl_prev=sl_cur;sl_cur=sl_next;sl_next=(sl_next==(NSLOT-1)*SLOTB)?0:sl_next+SLOTB;}while(0)
  DMA_K(2,2*SLOTB);
  WAIT_BAR(3);
  qkt(pA0,pA1,Kbase,qr,ZC,r32,hi);asm volatile("s_nop 15\n\ts_nop 7":"+v"(pA0),"+v"(pA1));CMASK(pA0,pA1,0);
  START(pA0,pA1);
  _Pragma("unroll") for(int r=0;r<16;++r)pA1[r]=__builtin_amdgcn_exp2f(pA1[r]);
  WAIT_BAR(0);
  DMA_K(3,0);DMA_V(1,SLOTB);
  ROT();
  kload8(kf,kp0+sl_cur);
  WAIT_BAR(3);
  s16x4 vlo[8],vhi[8]; u32x4 pw0,pw1,pw2,pw3;
  #define PKW(P,B) cvtpk_s(P[B],P[B+1])
  #define PAF(k) __builtin_bit_cast(bf16x8,pw##k)
  #define VFR(i) (bf16x8){vlo[i][0],vlo[i][1],vlo[i][2],vlo[i][3],vhi[i][0],vhi[i][1],vhi[i][2],vhi[i][3]}
  #define PIN(x) asm volatile("":"+v"(x))
  #define MX3(a,b,c) __builtin_fmaxf(__builtin_fmaxf((a),(b)),(c))
  #define GAPA(MF,A0,A1,A2,A3,W0,W1,PW) do{ MF; sacc+=A0; sacc+=A1; sacc+=A2; sacc+=A3; PIN(sacc); W0; W1; PIN(PW); SBAR(); }while(0)
  #define EX(v) __builtin_amdgcn_exp2f(v)
  #define GAPB(MF,X,B) do{ MF; X[B]=EX(X[B]-mhat); X[B+1]=EX(X[B+1]-mhat); X[B+2]=EX(X[B+2]-mhat); X[B+3]=EX(X[B+3]-mhat); PIN(X); SBAR(); }while(0)
  #define VRD(i) do{ vlo[i]=vtr(vp_+(((i)>>2)*4096+((i)&3)*1024)); vhi[i]=vtr(vp_+(((i)>>2)*4096+((i)&3)*1024+512)); }while(0)
  #define KRD(G,j) do{ if(G){ kload2(kf,kp0+sl_next,j); SBAR(); } }while(0)
  #define STEP(C0,C1,P0,P1,t,GK,GV,GL) do{ SBAR(); \
    const lds_cptr vp_=vp0+2*sl_prev; \
    VRD(0); SBAR(); float sacc=(P0[0]+P0[1]); \
    GAPA(C0=__builtin_amdgcn_mfma_f32_32x32x16_bf16(kf[0],qr[0],ZC,0,0,0), P0[2],P0[3],P0[4],P0[5],     pw0[0]=PKW(P0,0), pw0[1]=PKW(P0,2), pw0); \
    VRD(4); SBAR(); GAPA(C1=__builtin_amdgcn_mfma_f32_32x32x16_bf16(kf[1],qr[0],ZC,0,0,0), P0[6],P0[7],P0[8],P0[9],     pw0[2]=PKW(P0,4), pw0[3]=PKW(P0,6), pw0); \
    VRD(1); SBAR(); GAPA(C0=__builtin_amdgcn_mfma_f32_32x32x16_bf16(kf[2],qr[1],C0,0,0,0),   P0[10],P0[11],P0[12],P0[13], pw1[0]=PKW(P0,8), pw1[1]=PKW(P0,10), pw1); \
    VRD(5); SBAR(); GAPA(C1=__builtin_amdgcn_mfma_f32_32x32x16_bf16(kf[3],qr[1],C1,0,0,0),   P0[14],P0[15],P1[0],P1[1],   pw1[2]=PKW(P0,12),pw1[3]=PKW(P0,14), pw1); \
    VRD(2); SBAR(); GAPA(C0=__builtin_amdgcn_mfma_f32_32x32x16_bf16(kf[4],qr[2],C0,0,0,0),   P1[2],P1[3],P1[4],P1[5],     pw2[0]=PKW(P1,0), pw2[1]=PKW(P1,2), pw2); \
    VRD(6); SBAR(); GAPA(C1=__builtin_amdgcn_mfma_f32_32x32x16_bf16(kf[5],qr[2],C1,0,0,0),   P1[6],P1[7],P1[8],P1[9],     pw2[2]=PKW(P1,4), pw2[3]=PKW(P1,6), pw2); \
    VRD(3); SBAR(); GAPA(C0=__builtin_amdgcn_mfma_f32_32x32x16_bf16(kf[6],qr[3],C0,0,0,0),   P1[10],P1[11],P1[12],P1[13], pw3[0]=PKW(P1,8), pw3[1]=PKW(P1,10), pw3); \
    VRD(7); SBAR(); GAPA(C1=__builtin_amdgcn_mfma_f32_32x32x16_bf16(kf[7],qr[3],C1,0,0,0),   P1[14],P1[15],0.f,0.f,       pw3[2]=PKW(P1,12),pw3[3]=PKW(P1,14), pw3); \
    l_reg+=sacc; \
    if(GK){DMA_K((t)+3,sl_cur);} if(GV){DMA_V((t)+1,sl_next);} \
    CMASK(C0,C1,t); \
    { float a=MX3(C0[0],C0[1],C1[0]),b=MX3(C0[2],C0[3],C1[1]); a=MX3(a,C1[2],C1[3]); \
      _Pragma("unroll") for(int r=4;r<16;r+=4){a=MX3(a,C0[r],C0[r+1]);b=MX3(b,C0[r+2],C0[r+3]);a=MX3(a,C1[r],C1[r+1]);b=MX3(b,C1[r+2],C1[r+3]);} \
      float rm=__builtin_fmaxf(a,b); { auto rr=__builtin_amdgcn_permlane32_swap(__float_as_uint(rm),__float_as_uint(rm),false,false); rm=__builtin_fmaxf(__uint_as_float(rr[0]),__uint_as_float(rr[1])); } \
      resc=false; rm-=mhat; \
      if(__builtin_expect(__any(rm>(float)THRL),0)){ const float dl=__builtin_fmaxf(rm,0.f); mhat+=dl; \
        const float f=__builtin_amdgcn_exp2f(-dl); l_reg*=f; if(hi==0)wsf[r32]=f; resc=true; } } \
    SBAR(); \
    GAPB(o[0]=__builtin_amdgcn_mfma_f32_32x32x16_bf16(PAF(0),VFR(0),o[0],0,0,0), C0,0); \
    GAPB(o[1]=__builtin_amdgcn_mfma_f32_32x32x16_bf16(PAF(0),VFR(4),o[1],0,0,0), C0,4); \
    KRD(GL,0); GAPB(o[0]=__builtin_amdgcn_mfma_f32_32x32x16_bf16(PAF(1),VFR(1),o[0],0,0,0), C0,8); \
    KRD(GL,1); GAPB(o[1]=__builtin_amdgcn_mfma_f32_32x32x16_bf16(PAF(1),VFR(5),o[1],0,0,0), C0,12); \
    KRD(GL,2); GAPB(o[0]=__builtin_amdgcn_mfma_f32_32x32x16_bf16(PAF(2),VFR(2),o[0],0,0,0), C1,0); \
    KRD(GL,3); GAPB(o[1]=__builtin_amdgcn_mfma_f32_32x32x16_bf16(PAF(2),VFR(6),o[1],0,0,0), C1,4); \
    GAPB(o[0]=__builtin_amdgcn_mfma_f32_32x32x16_bf16(PAF(3),VFR(3),o[0],0,0,0), C1,8); \
    GAPB(o[1]=__builtin_amdgcn_mfma_f32_32x32x16_bf16(PAF(3),VFR(7),o[1],0,0,0), C1,12); \
    }while(0)
  #define PV2() do{ SBAR(); pv(o2,vb0+2*sl_prev+8192,PAF(0),PAF(1),PAF(2),PAF(3)); SBAR(); }while(0)
  int t=1;
  #undef CMASK
  #define CMASK(P0,P1,t) do{}while(0)
  for(;t+5<NT;t+=2){
    STEP(pB0,pB1,pA0,pA1,t,true,true,true);     PV2(); WAIT_BAR(3); RESC(); ROT();
    STEP(pA0,pA1,pB0,pB1,t+1,true,true,true);   PV2(); WAIT_BAR(3); RESC(); ROT();
  }
  #undef CMASK
  #define CMASK(P0,P1,t) do{int jb_=(t)-(NT-4); if(jb_>=0)cmask(P0,P1,jb_,qrel,hi);}while(0)
  #define ENDW(tt) do{ if((tt)+3<NT){WAIT_BAR(3);} else if((tt)+2<NT){WAIT_BAR(2);} else {WAIT_BAR(0);} }while(0)
  for(;t+1<NT;t+=2){
    STEP(pB0,pB1,pA0,pA1,t,(t+3<NT),(t+1<NT),(t+1<NT));       PV2(); ENDW(t);   RESC(); ROT();
    STEP(pA0,pA1,pB0,pB1,t+1,(t+4<NT),(t+2<NT),(t+2<NT));     PV2(); ENDW(t+1); RESC(); ROT();
  }
  STEP(pB0,pB1,pA0,pA1,NT-1,false,false,false); PV2(); RESC();
  { float sacc=pB0[0]+pB0[1]; _Pragma("unroll") for(int r=2;r<16;++r)sacc+=pB0[r]; _Pragma("unroll") for(int r=0;r<16;++r)sacc+=pB1[r]; l_reg+=sacc;
    pw0=(u32x4){PKW(pB0,0),PKW(pB0,2),PKW(pB0,4),PKW(pB0,6)};pw1=(u32x4){PKW(pB0,8),PKW(pB0,10),PKW(pB0,12),PKW(pB0,14)};pw2=(u32x4){PKW(pB1,0),PKW(pB1,2),PKW(pB1,4),PKW(pB1,6)};pw3=(u32x4){PKW(pB1,8),PKW(pB1,10),PKW(pB1,12),PKW(pB1,14)};
    SBAR(); pv(o,vb0+2*sl_cur,PAF(0),PAF(1),PAF(2),PAF(3)); SBAR(); pv(o2,vb0+2*sl_cur+8192,PAF(0),PAF(1),PAF(2),PAF(3)); }
  #undef PKW
  #undef PAF
  #undef VFR
  #undef PIN
  #undef MX3
  #undef GAPA
  #undef GAPB
  #undef EX
  #undef VRD
  #undef KRD
  #undef STEP
  #undef ENDW
  #undef PV2
  {auto rr=__builtin_amdgcn_permlane32_swap(__float_as_uint(l_reg),__float_as_uint(l_reg),false,false);l_reg=__uint_as_float(rr[0])+__uint_as_float(rr[1]);}
  if(hi==0)wsf[32+r32]=l_reg;asm volatile("s_waitcnt lgkmcnt(0)":::"memory");
  float rli[16];
  #pragma unroll
  for(int r=0;r<16;++r)rli[r]=__builtin_amdgcn_rcpf(wsf[32+crow(r,hi)]);
  bf16*Ow=Oh+(long)(q0+wid*QBLK)*opitch;
  { bf16*stg=(bf16*)(shm+LDS_OST)+wid*2048;
    #define OPASS(OO,COFF) do{ \
    _Pragma("unroll") for(int r=0;r<16;++r){const int orow=crow(r,hi); \
      _Pragma("unroll") for(int d0=0;d0<2;++d0)stg[orow*64+d0*32+r32]=__float2bfloat16(OO[d0][r]*rli[r]);} \
    asm volatile("s_waitcnt lgkmcnt(0)":::"memory"); \
    _Pragma("unroll") for(int i=0;i<4;++i){const int row=i*8+(lane>>3),ch=lane&7; const u32x4 v=*(const u32x4*)(stg+row*64+ch*8); ATTN_STORE16(Ow+(long)row*opitch+(COFF)+ch*8,v);} \
    asm volatile("s_waitcnt lgkmcnt(0)":::"memory"); }while(0)
    OPASS(o,0); OPASS(o2,64);
    #undef OPASS
  }
  asm volatile("s_waitcnt lgkmcnt(0)\n\ts_barrier":::"memory");
  #undef DMA_K
  #undef DMA_V
  #undef CMASK
  #undef START
  #undef RESC
  #undef ROT
}
constexpr int ATTN_LDS_BYTES=LDS_BYTES;
struct AttnTensors { const bf16* Q; const bf16* K; const bf16* V; bf16* O; };
struct AttnUnit { int bh; int qb; };
struct StaticOrder {
  int vcu;
  __device__ __forceinline__ explicit StaticOrder(int grid,int block):vcu((block%8)*(grid/8)+block/8){}
  __device__ __forceinline__ bool next(int i,AttnUnit&u)const{ if(i>=4)return false; const int s=vcu&15; u.bh=vcu>>4; const int ii=3-i; u.qb=(ii&1)?(32*(ii>>1)+31-s):(32*(ii>>1)+s); return true; }
  __device__ __forceinline__ void a_ready(const AttnUnit&)const{}
  __device__ __forceinline__ void done(const AttnUnit&)const{}
};
template<class Sched,int THRL=8> __device__ __forceinline__ void attn_phase(char*lds,const AttnTensors&T,const Sched&S,const int wave_s){
  AttnUnit u;
  for(int i=0;S.next(i,u);++i){ const int j=u.bh; attn_unit<THRL>(u.qb,T.Q+64*j,T.K+64*j,T.V+128*(j>>1),T.O+128*j,2048,lds,wave_s); }
}
#undef SBAR
#undef WAIT_BAR
}
#define GAS __attribute__((address_space(1)))
#define LAS __attribute__((address_space(3)))
typedef unsigned short bf16;
typedef unsigned v4u __attribute__((ext_vector_type(4)));
typedef unsigned v2u __attribute__((ext_vector_type(2)));
typedef float f32x4 __attribute__((ext_vector_type(4)));
typedef float f32x2 __attribute__((ext_vector_type(2)));
typedef short bf16x8 __attribute__((ext_vector_type(8)));
#define LDS_WAIT() asm volatile("s_waitcnt lgkmcnt(0)" ::: "memory")

constexpr int M = 16384, D = 1024, FF = 2816, NCHUNK = 256;
constexpr size_t MiB = 1u << 20;
constexpr size_t WS_WGU = 2 * MiB, WS_WD = 46 * MiB, WS_WGLU = 68 * MiB, WS_WIN = 76 * MiB, WS_WOG = 83 * MiB, WS_WQKV = 85 * MiB, WS_WOD = 91 * MiB;
constexpr size_t WS_S5P = 93 * MiB, WS_SSQ = 95 * MiB, WS_XN = 98 * MiB, WS_SCR = 130 * MiB, WS_END = 324 * MiB;
constexpr size_t S5P_LAM = 0, S5P_L64 = 32768, S5P_BB = 65536, S5P_CT = 65536 + 524288;
constexpr size_t SC_H = 0;
constexpr size_t SC_Z = 0, SC_SLOC = 32 * MiB, SC_CAR = 40 * MiB;
constexpr size_t SC_GQ = 0, SC_GK = 16 * MiB, SC_GV = 32 * MiB, SC_GSG = 64 * MiB, SC_GLA = 96 * MiB, SC_GUPD = 128 * MiB, SC_GDEC = 192 * MiB, SC_GO2 = SC_GV;
constexpr size_t SC_DQ = 0, SC_DK = 32 * MiB, SC_DV = 64 * MiB, SC_DO = 96 * MiB, SC_DOC = 160 * MiB;
static_assert(SC_GK == 16 * MiB && SC_GV == 32 * MiB && SC_GSG == 64 * MiB && SC_DK == 32 * MiB && SC_DV == 64 * MiB, "epilogue element offsets");
constexpr int LDS_BYTES = 147456;
constexpr int NWAVES = 8;
constexpr float LAMBDA_INIT = 0.4707130183435842f;

__device__ __forceinline__ unsigned f2bf(float f) { unsigned u = __builtin_bit_cast(unsigned, f); return (u + 0x7fffu + ((u >> 16) & 1u)) >> 16; }
__device__ __forceinline__ unsigned pk2(float lo, float hi) { return f2bf(lo) | (f2bf(hi) << 16); }
__device__ __forceinline__ float bf_lo(unsigned w) { return __builtin_bit_cast(float, w << 16); }
__device__ __forceinline__ float bf_hi(unsigned w) { return __builtin_bit_cast(float, w & 0xffff0000u); }
__device__ __forceinline__ float bf2f(bf16 b) { return __builtin_bit_cast(float, (unsigned)b << 16); }
__device__ __forceinline__ float wave_sum(float v) {
#pragma unroll
    for (int o = 1; o < 64; o <<= 1) v += shx(v, o);
    return v;
}

#define XB_TMO      128
#define XB_XCNT(j)  (256  + 64 * (j))
#define XB_XSUB(j)  (1280 + 64 * (j))
#define XB_XGEN(j)  (2304 + 64 * (j))
#define XB_TOP      3328
#define XB_TOPGEN   3392
#define XCD_BAR_WORDS 3456
#define XB_SPIN_CAP (1u << 18)

__device__ __forceinline__ unsigned xb_ld(unsigned* p)              { return __hip_atomic_load(p, __ATOMIC_RELAXED, __HIP_MEMORY_SCOPE_AGENT); }
__device__ __forceinline__ unsigned xb_add(unsigned* p, unsigned v) { return __hip_atomic_fetch_add(p, v, __ATOMIC_RELAXED, __HIP_MEMORY_SCOPE_AGENT); }
__device__ __forceinline__ unsigned xb_xcc_id() { return (unsigned)__builtin_amdgcn_s_getreg((3 << 11) | 20) & 0xFu; }
#define XB_SPIN(cond, bar) do { unsigned _sp = 0; while (cond) { __builtin_amdgcn_s_sleep(1); \
    if ((++_sp & 255u) == 0u) { if (xb_ld(&(bar)[XB_TMO])) break; if (_sp > XB_SPIN_CAP) { atomicAdd(&(bar)[XB_TMO], 1u); break; } } } } while (0)

struct XcdBarrier {
    unsigned* bar; unsigned x;
    volatile LAS unsigned* st;
};

__device__ __forceinline__ XcdBarrier xcd_barrier_post(unsigned* bar, volatile LAS unsigned* st) {
    XcdBarrier b; b.bar = bar; b.x = xb_xcc_id(); b.st = st;
    if (threadIdx.x == 0) (void)xb_add(&bar[XB_XCNT(b.x)], 1u);
    return b;
}
__device__ __forceinline__ void xcd_barrier_complete(unsigned* bar, unsigned x, unsigned& nloc, unsigned& nx) {
    const unsigned G = gridDim.x * gridDim.y * gridDim.z;
    unsigned sum, cnt, mine, sp = 0u;
    for (;;) {
        sum = 0u; cnt = 0u; mine = 0u;
#pragma unroll
        for (unsigned j = 0; j < 16; ++j) { const unsigned c = xb_ld(&bar[XB_XCNT(j)]); sum += c; cnt += (c > 0u) ? 1u : 0u; mine = (j == x) ? c : mine; }
        if (sum == G) break;
        __builtin_amdgcn_s_sleep(1);
        if ((++sp & 255u) == 0u) { if (xb_ld(&bar[XB_TMO])) break; if (sp > XB_SPIN_CAP) { atomicAdd(&bar[XB_TMO], 1u); break; } }
    }
    nloc = mine > 0u ? mine : 1u; nx = cnt > 0u ? cnt : 1u;
}

__device__ __forceinline__ void xcd_barrier(const XcdBarrier& b, const bool is_t0) {
    asm volatile("s_waitcnt vmcnt(0)" ::: "memory");
    __syncthreads();
    if (is_t0) {
        unsigned* bar = b.bar;
        __builtin_amdgcn_s_waitcnt(0);
        unsigned nloc = b.st[0], nx = b.st[1];
        if (nloc == 0u) { xcd_barrier_complete(bar, b.x, nloc, nx); b.st[0] = nloc; b.st[1] = nx; }
        const unsigned old = xb_add(&bar[XB_XSUB(b.x)], 1u);
        const unsigned gen = old / nloc;
        if (old + 1u == (gen + 1u) * nloc) {
            __builtin_amdgcn_fence(__ATOMIC_RELEASE, "agent");
            asm volatile("s_waitcnt vmcnt(0)" ::: "memory");
            const unsigned og = xb_add(&bar[XB_TOP], 1u);
            const unsigned tg = og / nx;
            if (og + 1u == (tg + 1u) * nx) xb_add(&bar[XB_TOPGEN], 1u);
            else XB_SPIN(xb_ld(&bar[XB_TOPGEN]) == tg, bar);
            __builtin_amdgcn_fence(__ATOMIC_ACQUIRE, "agent");
            xb_add(&bar[XB_XGEN(b.x)], 1u);
            asm volatile("s_waitcnt vmcnt(0)" ::: "memory");
        } else {
            XB_SPIN(xb_ld(&bar[XB_XGEN(b.x)]) == gen, bar);
            __builtin_amdgcn_fence(__ATOMIC_ACQUIRE, "agent");
            asm volatile("s_waitcnt vmcnt(0)" ::: "memory");
        }
    }
    __syncthreads();
}

constexpr size_t WS_BAR = 1 * MiB + 65536;
constexpr int MISC_OFF = 147456 - 256;

struct Args {
    const float* x; const int* pos; const float *norm_mix, *norm_ffn, *norm_final;
    const float *s5_lam_re, *s5_lam_im, *s5_log_dt, *s5_b_re, *s5_b_im, *s5_c_re, *s5_c_im, *s5_d, *s5_w_glu;
    const float *gla_w_in, *gla_w_a2, *gla_b_a, *gla_norm, *gla_w_o;
    const float *diff_w_qkv, *diff_lq1, *diff_lk1, *diff_lq2, *diff_lk2, *diff_subln, *diff_w_o;
    const float *ffn_w_gu, *ffn_w_d;
    float* out; unsigned char* ws;
};

#define KA(f) (*(volatile const __attribute__((address_space(4))) decltype(Args::f)*)((const __attribute__((address_space(4))) char*)__builtin_amdgcn_kernarg_segment_ptr() + offsetof(Args, f)))
__device__ __forceinline__ void transpose_item(const float* W, int ldw, int K, bf16* WT, int k0, int n0, int drow0, LAS float* scr, int lane, const float* gsc) {
    float wv[32];
    const float* wp = W + (size_t)(k0 + (lane >> 5)) * ldw + n0 + (lane & 31);
#pragma unroll
    for (int i = 0; i < 32; ++i) wv[i] = __builtin_nontemporal_load(wp + (size_t)(2 * i) * ldw);
    if (gsc) {
#pragma unroll
        for (int i = 0; i < 32; ++i) wv[i] *= gsc[k0 + 2 * i + (lane >> 5)]; }
#pragma unroll
    for (int i = 0; i < 32; ++i) scr[(2 * i + (lane >> 5)) * 33 + (lane & 31)] = wv[i];
    LDS_WAIT();
    const int c = lane & 7;
#pragma unroll
    for (int j = 0; j < 4; ++j) { const int n = (lane >> 3) + 8 * j; const LAS float* s = scr + (8 * c) * 33 + n;
        v4u o; o.x = pk2(s[0 * 33], s[1 * 33]); o.y = pk2(s[2 * 33], s[3 * 33]); o.z = pk2(s[4 * 33], s[5 * 33]); o.w = pk2(s[6 * 33], s[7 * 33]);
        *(v4u*)(WT + (size_t)(drow0 + n) * K + k0 + 8 * c) = o; }
    LDS_WAIT();
}

__device__ __forceinline__ void convert_set(const int set, const int wk, const int nwk, const int wblk, const int nwblk, LAS unsigned char* lds, int tid, int lane, int wave) {
    unsigned char* ws = KA(ws);
    LAS float* scr = (LAS float*)(lds + wave * 16384);
    constexpr int I_GU = 16 * 176, I_D = 44 * 32, I_GLU = 16 * 64, I_IN = 16 * 96, I_SQ = 16 * 32;
    const bool s5set = (set == 0 || set == 3);
    const int nitems = I_GU + I_D + (s5set ? I_GLU : I_IN + I_SQ);
    for (int it = wk; it < nitems; it += nwk) {
        int r = it; const float* W; bf16* WT; int ldw, K, ncols, inter = 0; const float* gsc = nullptr;
        if (r < I_GU) { W = KA(ffn_w_gu) + (size_t)set * 1024 * 5632; WT = (bf16*)(ws + WS_WGU) + (size_t)set * 5632 * 1024; ldw = 5632; K = 1024; ncols = 5632; inter = 2816; gsc = KA(norm_ffn) + set * 1024; }
        else if ((r -= I_GU) < I_D) { W = KA(ffn_w_d) + (size_t)set * 2816 * 1024; WT = (bf16*)(ws + WS_WD) + (size_t)set * 1024 * 2816; ldw = 1024; K = 2816; ncols = 1024; }
        else { r -= I_D;
            if (s5set) { const int L = (set == 3) ? 1 : 0; W = KA(s5_w_glu) + (size_t)L * 1024 * 2048; WT = (bf16*)(ws + WS_WGLU) + (size_t)L * 2048 * 1024; ldw = 2048; K = 1024; ncols = 2048; inter = 1024; }
            else if (set == 1) { if (r < I_IN) { W = KA(gla_w_in); WT = (bf16*)(ws + WS_WIN); ldw = 3088; K = 1024; ncols = 3072; gsc = KA(norm_mix) + 1 * 1024; }
                                 else { r -= I_IN; W = KA(gla_w_o); WT = (bf16*)(ws + WS_WOG); ldw = 1024; K = 1024; ncols = 1024; } }
            else { if (r < I_IN) { W = KA(diff_w_qkv); WT = (bf16*)(ws + WS_WQKV); ldw = 3072; K = 1024; ncols = 3072; gsc = KA(norm_mix) + 2 * 1024; }
                   else { r -= I_IN; W = KA(diff_w_o); WT = (bf16*)(ws + WS_WOD); ldw = 1024; K = 1024; ncols = 1024; } }
        }
        const int nblk = ncols / 32, kb = r / nblk, nb = r - kb * nblk, n0 = nb * 32;
        int drow0 = n0;
        if (inter) { if (n0 < inter) drow0 = 256 * (n0 >> 7) + (n0 & 127); else { const int n1 = n0 - inter; drow0 = 256 * (n1 >> 7) + 128 + (n1 & 127); } }
        transpose_item(W, ldw, K, WT, kb * 64, n0, drow0, scr, lane, gsc);
    }
    if (set == 1) {
        bf16* WT = (bf16*)(ws + WS_WIN) + (size_t)3072 * 1024;
        for (int e = wblk * 512 + tid; e < 512 * 1024; e += nwblk * 512) {
            const int k = e & 1023, j = e >> 10; float s = 0.f;
            const float* wi = KA(gla_w_in) + (size_t)k * 3088 + 3072;
#pragma unroll
            for (int r = 0; r < 16; ++r) s += wi[r] * KA(gla_w_a2)[r * 512 + j];
            WT[(size_t)j * 1024 + k] = (bf16)f2bf(s * KA(norm_mix)[1024 + k]);
        }
    }
}
__device__ __forceinline__ void prologue(LAS unsigned char* lds, int tid, int lane, int wave) {
    unsigned char* ws = KA(ws);
    const int gw = blockIdx.x * NWAVES + wave, NGW = gridDim.x * NWAVES;
    convert_set(0, gw, NGW, (int)blockIdx.x, (int)gridDim.x, lds, tid, lane, wave);
    {
        bf16* XN = (bf16*)(ws + WS_XN); float* SSQ = (float*)(ws + WS_SSQ);
        const float* xin = KA(x);
        for (int m = 2 * gw; m < M; m += 2 * NGW) {
            const f32x4* xr = (const f32x4*)(xin + (size_t)m * D) + lane;
            f32x4 v[8];
#pragma unroll
            for (int j = 0; j < 8; ++j) v[j] = __builtin_nontemporal_load(xr + 64 * j);
#pragma unroll
            for (int rr = 0; rr < 2; ++rr) { float s = 0.f; v2u* o8 = (v2u*)(XN + (size_t)(m + rr) * D) + lane;
#pragma unroll
                for (int j = 0; j < 4; ++j) { const f32x4 x4 = v[4 * rr + j]; s += (x4[0] * x4[0] + x4[1] * x4[1]) + (x4[2] * x4[2] + x4[3] * x4[3]);
                    v2u w; w.x = pk2(x4[0], x4[1]); w.y = pk2(x4[2], x4[3]); o8[64 * j] = w; }
                s = wave_sum(s);
                if (lane < 32) SSQ[(size_t)(m + rr) * 32 + lane] = (lane == 0) ? s : 0.f; }
        }
    }
    for (int e = blockIdx.x * 512 + tid; e < 2 * 4096; e += gridDim.x * 512) {
        const int li = e >> 12, gp = e & 4095, g = gp >> 6, p = gp & 63;
        unsigned char* pb = ws + WS_S5P + (size_t)li * MiB;
        const double lr = (double)KA(s5_lam_re)[li * 4096 + gp], lim = (double)KA(s5_lam_im)[li * 4096 + gp], dt = exp((double)KA(s5_log_dt)[li * 64 + g]);
        const double mag = exp(lr * dt), ang = lim * dt, abr = mag * cos(ang), abi = mag * sin(ang);
        const double den = lr * lr + lim * lim, fre = ((abr - 1.0) * lr + abi * lim) / den, fim = (abi * lr - (abr - 1.0) * lim) / den;
        const double mag64 = exp(lr * dt * 64.0), ang64 = lim * dt * 64.0;
        ((f32x2*)(pb + S5P_LAM))[gp] = (f32x2){(float)abr, (float)abi};
        ((f32x2*)(pb + S5P_L64))[gp] = (f32x2){(float)(mag64 * cos(ang64)), (float)(mag64 * sin(ang64))};
        bf16* BBh = (bf16*)(pb + S5P_BB);
        const float* bre = KA(s5_b_re) + ((size_t)li * 4096 + gp) * 16; const float* bim = KA(s5_b_im) + ((size_t)li * 4096 + gp) * 16;
#pragma unroll
        for (int h = 0; h < 16; ++h) { const double gk = (double)KA(norm_mix)[(li * 3) * 1024 + 16 * g + h]; const double br = (double)bre[h] * gk, bi = (double)bim[h] * gk;
            BBh[(g * 128 + p) * 16 + h] = (bf16)f2bf((float)(fre * br - fim * bi)); BBh[(g * 128 + 64 + p) * 16 + h] = (bf16)f2bf((float)(fre * bi + fim * br)); }
        bf16* CT = (bf16*)(pb + S5P_CT);
#pragma unroll
        for (int h = 0; h < 16; ++h) { const size_t ci = (((size_t)li * 64 + g) * 16 + h) * 64 + p;
            CT[(g * 16 + h) * 128 + 2 * p] = (bf16)f2bf(KA(s5_c_re)[ci]); CT[(g * 16 + h) * 128 + 2 * p + 1] = (bf16)f2bf(-KA(s5_c_im)[ci]); }
    }
}

typedef short s16x4 __attribute__((ext_vector_type(4)));
__device__ __forceinline__ void s5_rstd_table(const float* SSQ, int c, int tid, LAS float* rstdL) {
    __syncthreads();
    if (tid < 64) { const f32x4* p = (const f32x4*)(SSQ + (size_t)(64 * c + tid) * 32); float s = 0.f;
#pragma unroll
        for (int i = 0; i < 8; ++i) { const f32x4 v = p[i]; s += (v[0] + v[1]) + (v[2] + v[3]); }
        rstdL[tid] = __builtin_amdgcn_rsqf(s * (1.0f / 1024.0f) + 1e-6f); }
    __syncthreads();
}
__device__ __forceinline__ void s5_bu_block(const s16x4 av, const s16x4 (&bw)[8], const LAS float* rstdL, int tb, LAS float* BU, int col, int quad) {
    const f32x4 rs = *(const LAS f32x4*)(rstdL + 16 * tb + 4 * quad);
#pragma unroll
    for (int nt = 0; nt < 8; ++nt) {
        f32x4 d = __builtin_amdgcn_mfma_f32_16x16x16bf16_1k(av, bw[nt], (f32x4){0.f, 0.f, 0.f, 0.f}, 0, 0, 0);
        *(LAS f32x4*)(BU + (16 * nt + col) * 20 + 4 * quad) = d * rs;
    }
    LDS_WAIT();
}
struct S5Ops { s16x4 av[4]; s16x4 bw[8]; f32x2 lam; };
__device__ __forceinline__ void s5_load_ops(S5Ops& o, const bf16* XN, const bf16* BBh, const f32x2* LAM, int c, int g, int lane, int col, int quad) {
#pragma unroll
    for (int tb = 0; tb < 4; ++tb) o.av[tb] = *(const s16x4*)(XN + (size_t)(64 * c + 16 * tb + col) * D + 16 * g + 4 * quad);
#pragma unroll
    for (int nt = 0; nt < 8; ++nt) o.bw[nt] = *(const s16x4*)(BBh + (size_t)(g * 128 + 16 * nt + col) * 16 + 4 * quad);
    o.lam = LAM[g * 64 + lane];
}
__device__ __forceinline__ void s5_phaseA(const unsigned char* pb, const bf16* XN, const float* SSQ, f32x2* SLOC, LAS unsigned char* lds, int tid, int lane, int wave) {
    LAS float* rstdL = (LAS float*)lds; LAS float* BU = (LAS float*)(lds + 1024 + wave * 14592);
    const f32x2* LAM = (const f32x2*)(pb + S5P_LAM); const bf16* BBh = (const bf16*)(pb + S5P_BB);
    const int col = lane & 15, quad = lane >> 4;
    for (int c = blockIdx.x; c < NCHUNK; c += gridDim.x) {
        S5Ops cur; s5_load_ops(cur, XN, BBh, LAM, c, wave * 8, lane, col, quad);
        s5_rstd_table(SSQ, c, tid, rstdL);
        for (int gi = 0; gi < 8; ++gi) {
            const int g = wave * 8 + gi;
            S5Ops nxt; s5_load_ops(nxt, XN, BBh, LAM, c, wave * 8 + ((gi + 1) & 7), lane, col, quad);
            float sre = 0.f, sim = 0.f;
#pragma unroll
            for (int tb = 0; tb < 4; ++tb) {
                s5_bu_block(cur.av[tb], cur.bw, rstdL, tb, BU, col, quad);
#pragma unroll
                for (int t4 = 0; t4 < 4; ++t4) { const f32x4 br4 = *(const LAS f32x4*)(BU + lane * 20 + 4 * t4), bi4 = *(const LAS f32x4*)(BU + (64 + lane) * 20 + 4 * t4);
#pragma unroll
                    for (int q = 0; q < 4; ++q) { const float nre = cur.lam[0] * sre - cur.lam[1] * sim + br4[q], nim = cur.lam[0] * sim + cur.lam[1] * sre + bi4[q]; sre = nre; sim = nim; } }
                LDS_WAIT();
            }
            SLOC[(size_t)(c * 64 + g) * 64 + lane] = (f32x2){sre, sim};
            cur = nxt;
        }
    }
}
__device__ __forceinline__ f32x2 cmul(const f32x2 a, const f32x2 b) { return (f32x2){a[0] * b[0] - a[1] * b[1], a[0] * b[1] + a[1] * b[0]}; }
__device__ __forceinline__ void s5_phaseB(const unsigned char* pb, const f32x2* SLOC, f32x2* CAR, LAS unsigned char* lds, int tid) {
    LAS f32x2* EX = (LAS f32x2*)lds;
    const int gl = tid & 31, seg = tid >> 5;
    for (int it = blockIdx.x; it < 128; it += gridDim.x) {
        const int gid = it * 32 + gl; const f32x2 l = ((const f32x2*)(pb + S5P_L64))[gid];
        f32x2 v[16];
#pragma unroll
        for (int i = 0; i < 16; ++i) v[i] = SLOC[(size_t)(16 * seg + i) * 4096 + gid];
        f32x2 s = (f32x2){0.f, 0.f};
#pragma unroll
        for (int i = 0; i < 16; ++i) { const f32x2 in = s; s = cmul(l, s) + v[i]; v[i] = in; }
        __syncthreads();
        EX[seg * 32 + gl] = s;
        __syncthreads();
        f32x2 l16 = cmul(l, l); l16 = cmul(l16, l16); l16 = cmul(l16, l16); l16 = cmul(l16, l16);
        f32x2 S = (f32x2){0.f, 0.f};
#pragma unroll
        for (int sp = 0; sp < 15; ++sp) { const f32x2 e = EX[sp * 32 + gl]; if (sp < seg) S = cmul(l16, S) + e; }
        f32x2 p = (f32x2){1.f, 0.f};
#pragma unroll
        for (int i = 0; i < 16; ++i) { CAR[(size_t)(16 * seg + i) * 4096 + gid] = v[i] + cmul(p, S); p = cmul(p, l); }
    }
}
struct S5OpsC { bf16x8 cf[4]; f32x2 s0; float dsk; };
__device__ __forceinline__ void s5_load_opsC(S5OpsC& o, const bf16* XN, const bf16* CT, const f32x2* CAR, const float* dskip, const float* gmix, int c, int g, int lane, int col, int quad) {
#pragma unroll
    for (int ks = 0; ks < 4; ++ks) o.cf[ks] = *(const bf16x8*)(CT + (g * 16 + col) * 128 + 32 * ks + 8 * quad);
    o.s0 = CAR[(size_t)(c * 64 + g) * 64 + lane]; o.dsk = dskip[16 * g + col] * gmix[16 * g + col];
}
__device__ __forceinline__ void s5_phaseC(const unsigned char* pb, const bf16* XN, const float* SSQ, const f32x2* CAR, const float* dskip, const float* gmix, bf16* Z, LAS unsigned char* lds, int tid, int lane, int wave) {
    LAS float* rstdL = (LAS float*)lds; LAS float* BU = (LAS float*)(lds + 1024 + wave * 14592); LAS unsigned* SL = (LAS unsigned*)(lds + 1024 + wave * 14592 + 10240);
    LAS bf16* HT = (LAS bf16*)(lds + 1024 + 8 * 14592 + wave * 2048);
    const f32x2* LAM = (const f32x2*)(pb + S5P_LAM); const bf16* BBh = (const bf16*)(pb + S5P_BB); const bf16* CT = (const bf16*)(pb + S5P_CT);
    const int col = lane & 15, quad = lane >> 4;
    for (int c = blockIdx.x; c < NCHUNK; c += gridDim.x) {
        S5Ops cur; S5OpsC curc; s5_load_ops(cur, XN, BBh, LAM, c, wave * 8, lane, col, quad); s5_load_opsC(curc, XN, CT, CAR, dskip, gmix, c, wave * 8, lane, col, quad);
        s5_rstd_table(SSQ, c, tid, rstdL);
        for (int gi = 0; gi < 8; ++gi) {
            const int g = wave * 8 + gi, gn = wave * 8 + ((gi + 1) & 7);
            S5Ops nxt; S5OpsC nxtc; s5_load_ops(nxt, XN, BBh, LAM, c, gn, lane, col, quad); s5_load_opsC(nxtc, XN, CT, CAR, dskip, gmix, c, gn, lane, col, quad);
            float sre = curc.s0[0], sim = curc.s0[1];
#pragma unroll
            for (int tb = 0; tb < 4; ++tb) *(LAS s16x4*)(HT + (16 * tb + col) * 16 + 4 * quad) = cur.av[tb];
#pragma unroll
            for (int tb = 0; tb < 4; ++tb) {
                s5_bu_block(cur.av[tb], cur.bw, rstdL, tb, BU, col, quad);
#pragma unroll
                for (int t4 = 0; t4 < 4; ++t4) { const f32x4 br4 = *(const LAS f32x4*)(BU + lane * 20 + 4 * t4), bi4 = *(const LAS f32x4*)(BU + (64 + lane) * 20 + 4 * t4);
#pragma unroll
                    for (int q = 0; q < 4; ++q) { const float nre = cur.lam[0] * sre - cur.lam[1] * sim + br4[q], nim = cur.lam[0] * sim + cur.lam[1] * sre + bi4[q]; sre = nre; sim = nim;
                        SL[(4 * t4 + q) * 68 + lane] = pg8::cvt_pk_bf16(sre, sim); } }
                LDS_WAIT();
                f32x4 acc = (f32x4){0.f, 0.f, 0.f, 0.f};
#pragma unroll
                for (int ks = 0; ks < 4; ++ks) { const bf16x8 a8 = *(const LAS bf16x8*)((const LAS unsigned char*)SL + col * 272 + 64 * ks + 16 * quad); acc = __builtin_amdgcn_mfma_f32_16x16x32_bf16(a8, curc.cf[ks], acc, 0, 0, 0); }
                const f32x4 rs = *(const LAS f32x4*)(rstdL + 16 * tb + 4 * quad);
#pragma unroll
                for (int j = 0; j < 4; ++j) { const int tl = 16 * tb + 4 * quad + j; const float y = acc[j] + curc.dsk * (bf2f(HT[tl * 16 + col]) * rs[j]);
                    const float a2 = 1.5957691216057308f * (y + 0.044715f * y * y * y); const float z = y * __builtin_amdgcn_rcpf(1.0f + __builtin_amdgcn_exp2f(-1.4426950408889634f * a2));
                    Z[(size_t)(64 * c + tl) * D + 16 * g + col] = (bf16)f2bf(z); }
                LDS_WAIT();
            }
            cur = nxt; curc = nxtc;
        }
    }
}

__device__ __forceinline__ void gla_g1(const bf16* Kb, const bf16* Vb, const float* LA, bf16* UPD, float* DEC, LAS unsigned char* lds, int tid, int lane, int wave) {
    LAS bf16* KD = (LAS bf16*)lds; LAS bf16* VT = (LAS bf16*)(lds + 18432);
    LAS float* SEG = (LAS float*)(lds + 55296);
    LAS bf16* OST = (LAS bf16*)(lds + 57344 + wave * 8704);
    const int col = lane & 15, quad = lane >> 4;
    for (int item = blockIdx.x; item < 1024; item += gridDim.x) {
        const int c = item >> 2, h = item & 3;
        const int dk = tid & 127, tq = tid >> 7, dv = tid & 255, th = tid >> 8;
        float la[16]; unsigned short kk[16], vv[32];
#pragma unroll
        for (int i = 0; i < 16; ++i) { const size_t r = (size_t)(64 * c + 16 * tq + i) * 512 + 128 * h + dk; la[i] = __builtin_nontemporal_load(LA + r); kk[i] = __builtin_nontemporal_load(Kb + r); }
#pragma unroll
        for (int i = 0; i < 32; ++i) vv[i] = __builtin_nontemporal_load(Vb + (size_t)(64 * c + 32 * th + i) * 1024 + 256 * h + dv);
        __syncthreads();
#pragma unroll
        for (int i = 1; i < 16; ++i) la[i] += la[i - 1];
        SEG[tq * 128 + dk] = la[15];
#pragma unroll
        for (int i8 = 0; i8 < 4; ++i8) { v4u w; w.x = vv[8 * i8] | ((unsigned)vv[8 * i8 + 1] << 16); w.y = vv[8 * i8 + 2] | ((unsigned)vv[8 * i8 + 3] << 16);
            w.z = vv[8 * i8 + 4] | ((unsigned)vv[8 * i8 + 5] << 16); w.w = vv[8 * i8 + 6] | ((unsigned)vv[8 * i8 + 7] << 16);
            *(LAS v4u*)(VT + dv * 72 + 32 * th + 8 * i8) = w; }
        __syncthreads();
        { const float s0 = SEG[dk], s1 = SEG[128 + dk], s2 = SEG[256 + dk], s3 = SEG[384 + dk];
          const float off = (tq > 0 ? s0 : 0.f) + (tq > 1 ? s1 : 0.f) + (tq > 2 ? s2 : 0.f); const float tot = (s0 + s1) + (s2 + s3);
          if (tq == 0) DEC[(c * 4 + h) * 128 + dk] = __expf(tot);
          float kd[16];
#pragma unroll
          for (int i = 0; i < 16; ++i) kd[i] = bf2f(kk[i]) * __expf(tot - (off + la[i]));
#pragma unroll
          for (int i8 = 0; i8 < 2; ++i8) { v4u w; w.x = pk2(kd[8 * i8], kd[8 * i8 + 1]); w.y = pk2(kd[8 * i8 + 2], kd[8 * i8 + 3]); w.z = pk2(kd[8 * i8 + 4], kd[8 * i8 + 5]); w.w = pk2(kd[8 * i8 + 6], kd[8 * i8 + 7]);
              *(LAS v4u*)(KD + dk * 72 + 16 * tq + 8 * i8) = w; } }
        __syncthreads();
        bf16x8 bfr[2][2];
#pragma unroll
        for (int n2 = 0; n2 < 2; ++n2)
#pragma unroll
            for (int ks = 0; ks < 2; ++ks) bfr[n2][ks] = *(const LAS bf16x8*)(VT + (16 * (2 * wave + n2) + col) * 72 + 32 * ks + 8 * quad);
#pragma unroll
        for (int mt = 0; mt < 8; ++mt) {
            const bf16x8 a0 = *(const LAS bf16x8*)(KD + (16 * mt + col) * 72 + 8 * quad), a1 = *(const LAS bf16x8*)(KD + (16 * mt + col) * 72 + 32 + 8 * quad);
#pragma unroll
            for (int n2 = 0; n2 < 2; ++n2) {
                f32x4 acc = (f32x4){0.f, 0.f, 0.f, 0.f};
                acc = __builtin_amdgcn_mfma_f32_16x16x32_bf16(a0, bfr[n2][0], acc, 0, 0, 0); acc = __builtin_amdgcn_mfma_f32_16x16x32_bf16(a1, bfr[n2][1], acc, 0, 0, 0);
                v2u w; w.x = pk2(acc[0], acc[1]); w.y = pk2(acc[2], acc[3]);
                *(LAS v2u*)(OST + (16 * n2 + col) * 136 + 16 * mt + 4 * quad) = w;
            }
        }
        LDS_WAIT();
        bf16* out = UPD + ((size_t)(c * 4 + h) * 256 + 32 * wave) * 128;
#pragma unroll
        for (int i = 0; i < 8; ++i) { const int row = 4 * i + (lane >> 4), ch = lane & 15; const v4u v = *(const LAS v4u*)(OST + row * 136 + 8 * ch); *(v4u*)(out + (size_t)row * 128 + 8 * ch) = v; }
    }
}
__device__ __forceinline__ void gla_g2(bf16* UPD, const float* DEC, LAS unsigned char* lds, int tid) {
    LAS f32x4* EX = (LAS f32x4*)lds;
    const unsigned el = (unsigned)tid & 31u, seg = ((unsigned)tid >> 5) & 15u;
    for (unsigned it = blockIdx.x; it < 1024u; it += gridDim.x) {
        const unsigned e = ((it * 32u + el) * 4u) & 131071u, dk = e & 127u, h = e >> 15;
        const unsigned o0 = (16u * seg) * 131072u + e, q0 = (16u * seg * 4u + h) * 128u + dk;
        f32x4 u[16], d[16];
#pragma unroll
        for (unsigned i = 0; i < 16; ++i) { const v2u w = __builtin_nontemporal_load((const v2u*)(UPD + o0 + i * 131072u)); u[i] = (f32x4){bf_lo(w.x), bf_hi(w.x), bf_lo(w.y), bf_hi(w.y)}; d[i] = *(const f32x4*)(DEC + q0 + i * 512u); }
        f32x4 st = (f32x4){0.f, 0.f, 0.f, 0.f}, cp = (f32x4){1.f, 1.f, 1.f, 1.f};
#pragma unroll
        for (int i = 0; i < 16; ++i) { st = d[i] * st + u[i]; cp = cp * d[i]; u[i] = st; d[i] = cp; }
        __syncthreads();
        EX[(seg * 32 + el) * 2] = st; EX[(seg * 32 + el) * 2 + 1] = cp;
        __syncthreads();
        f32x4 S = (f32x4){0.f, 0.f, 0.f, 0.f};
#pragma unroll
        for (unsigned sp = 0; sp < 15; ++sp) { const f32x4 es = EX[(sp * 32 + el) * 2], ec = EX[(sp * 32 + el) * 2 + 1]; if (sp < seg) S = ec * S + es; }
#pragma unroll
        for (unsigned i = 0; i < 16; ++i) { const f32x4 r = u[i] + d[i] * S; v2u w; w.x = pk2(r[0], r[1]); w.y = pk2(r[2], r[3]); *(v2u*)(UPD + o0 + i * 131072u) = w; }
    }
}
__device__ __forceinline__ void gla_g3(const bf16* Qb, const bf16* ST, const bf16* SG, const float* gnorm, bf16* O2, LAS unsigned char* lds, int tid, int lane, int wave) {
    LAS float* P = (LAS float*)lds;
    const int col = lane & 15, quad = lane >> 4;
    for (int item = blockIdx.x; item < 1024; item += gridDim.x) {
        const int c = item >> 2, h = item & 3;
        const bf16* st = ST + (size_t)(c * 4 + h) * 256 * 128;
        bf16x8 af[2][4];
#pragma unroll
        for (int m2 = 0; m2 < 2; ++m2)
#pragma unroll
            for (int ks = 0; ks < 4; ++ks) af[m2][ks] = *(const bf16x8*)(st + (size_t)(16 * (2 * wave + m2) + col) * 128 + 32 * ks + 8 * quad);
        f32x4 acc[2][4];
#pragma unroll
        for (int nt = 0; nt < 4; ++nt) {
            bf16x8 bq[4];
#pragma unroll
            for (int ks = 0; ks < 4; ++ks) bq[ks] = *(const bf16x8*)(Qb + (size_t)(64 * c + 16 * nt + col) * 512 + 128 * h + 32 * ks + 8 * quad);
#pragma unroll
            for (int m2 = 0; m2 < 2; ++m2) { f32x4 r = (f32x4){0.f, 0.f, 0.f, 0.f};
#pragma unroll
                for (int ks = 0; ks < 4; ++ks) r = __builtin_amdgcn_mfma_f32_16x16x32_bf16(af[m2][ks], bq[ks], r, 0, 0, 0);
                acc[m2][nt] = r; }
        }
        __syncthreads();
#pragma unroll
        for (int nt = 0; nt < 4; ++nt) { float s = 0.f;
#pragma unroll
            for (int m2 = 0; m2 < 2; ++m2) { const f32x4 r = acc[m2][nt]; s += (r[0] * r[0] + r[1] * r[1]) + (r[2] * r[2] + r[3] * r[3]); }
            s += shx(s, 16); s += shx(s, 32);
            if (quad == 0) P[(16 * nt + col) * 8 + wave] = s; }
        __syncthreads();
#pragma unroll
        for (int nt = 0; nt < 4; ++nt) { const int t = 16 * nt + col; const LAS f32x4* pp = (const LAS f32x4*)(P + t * 8); const f32x4 p0 = pp[0], p1 = pp[1];
            const float tot = ((p0[0] + p0[1]) + (p0[2] + p0[3])) + ((p1[0] + p1[1]) + (p1[2] + p1[3])); const float rs = __builtin_amdgcn_rsqf(tot * (1.0f / 256.0f) + 1e-6f);
#pragma unroll
            for (int m2 = 0; m2 < 2; ++m2) { const int dv0 = 16 * (2 * wave + m2) + 4 * quad; const f32x4 ng = *(const f32x4*)(gnorm + 256 * h + dv0);
                const size_t off = (size_t)(64 * c + t) * 1024 + 256 * h + dv0; const v2u sg = *(const v2u*)(SG + off); const f32x4 r = acc[m2][nt];
                v2u w; w.x = pk2(r[0] * rs * ng[0] * bf_lo(sg.x), r[1] * rs * ng[1] * bf_hi(sg.x)); w.y = pk2(r[2] * rs * ng[2] * bf_lo(sg.y), r[3] * rs * ng[3] * bf_hi(sg.y));
                *(v2u*)(O2 + off) = w; } }
    }
}

__device__ __forceinline__ void diff_combine(const bf16* O, bf16* OC, int lane, int wave) {
    const float s1 = wave_sum(KA(diff_lq1)[lane] * KA(diff_lk1)[lane]), s2 = wave_sum(KA(diff_lq2)[lane] * KA(diff_lk2)[lane]);
    const float lamv = __expf(s1) - __expf(s2) + LAMBDA_INIT;
    const int h = lane >> 3, d0 = 16 * (lane & 7);
    f32x4 sg[4];
#pragma unroll
    for (int i = 0; i < 4; ++i) sg[i] = *(const f32x4*)(KA(diff_subln) + d0 + 4 * i);
    const int gw = blockIdx.x * NWAVES + wave, NGW = gridDim.x * NWAVES;
    for (int m = gw; m < M; m += NGW) {
        const v4u* p1 = (const v4u*)(O + (size_t)m * 2048 + 256 * h + d0); const v4u* p2 = (const v4u*)(O + (size_t)m * 2048 + 256 * h + 128 + d0);
        const v4u a0 = __builtin_nontemporal_load(p1), a1 = __builtin_nontemporal_load(p1 + 1), b0 = __builtin_nontemporal_load(p2), b1 = __builtin_nontemporal_load(p2 + 1);
        float d[16];
#define DC(i, wa, wb) d[2 * (i)] = bf_lo(wa) - lamv * bf_lo(wb); d[2 * (i) + 1] = bf_hi(wa) - lamv * bf_hi(wb);
        DC(0, a0.x, b0.x) DC(1, a0.y, b0.y) DC(2, a0.z, b0.z) DC(3, a0.w, b0.w) DC(4, a1.x, b1.x) DC(5, a1.y, b1.y) DC(6, a1.z, b1.z) DC(7, a1.w, b1.w)
#undef DC
        float s = 0.f;
#pragma unroll
        for (int i = 0; i < 16; ++i) s += d[i] * d[i];
        s += shx(s, 1); s += shx(s, 2); s += shx(s, 4);
        const float r = __builtin_amdgcn_rsqf(s * (1.0f / 128.0f) + 1e-5f) * (1.0f - LAMBDA_INIT);
        v4u w0, w1;
        w0.x = pk2(d[0] * r * sg[0][0], d[1] * r * sg[0][1]); w0.y = pk2(d[2] * r * sg[0][2], d[3] * r * sg[0][3]); w0.z = pk2(d[4] * r * sg[1][0], d[5] * r * sg[1][1]); w0.w = pk2(d[6] * r * sg[1][2], d[7] * r * sg[1][3]);
        w1.x = pk2(d[8] * r * sg[2][0], d[9] * r * sg[2][1]); w1.y = pk2(d[10] * r * sg[2][2], d[11] * r * sg[2][3]); w1.z = pk2(d[12] * r * sg[3][0], d[13] * r * sg[3][1]); w1.w = pk2(d[14] * r * sg[3][2], d[15] * r * sg[3][3]);
        v4u* o = (v4u*)(OC + (size_t)m * 1024 + 128 * h + d0); o[0] = w0; o[1] = w1;
    }
}
__device__ __forceinline__ void final_norm(const bf16* XB, float* out, const float* g, int lane, int wave) {
    const int gw = blockIdx.x * NWAVES + wave, NGW = gridDim.x * NWAVES;
    const f32x4* gr = (const f32x4*)g + 2 * lane;
    for (int m = 2 * gw; m < M; m += 2 * NGW) {
        const v4u* xr = (const v4u*)(XB + (size_t)m * D) + lane;
        v4u w[4];
#pragma unroll
        for (int j = 0; j < 4; ++j) w[j] = __builtin_nontemporal_load(xr + 64 * j);
#pragma unroll
        for (int rr = 0; rr < 2; ++rr) { float x[16]; float s = 0.f;
#pragma unroll
            for (int hf = 0; hf < 2; ++hf) { const v4u q = w[2 * rr + hf];
                x[8 * hf + 0] = bf_lo(q.x); x[8 * hf + 1] = bf_hi(q.x); x[8 * hf + 2] = bf_lo(q.y); x[8 * hf + 3] = bf_hi(q.y); x[8 * hf + 4] = bf_lo(q.z); x[8 * hf + 5] = bf_hi(q.z); x[8 * hf + 6] = bf_lo(q.w); x[8 * hf + 7] = bf_hi(q.w); }
#pragma unroll
            for (int i = 0; i < 16; ++i) s += x[i] * x[i];
            const float rs = 1.0f / sqrtf(wave_sum(s) * (1.0f / D) + 1e-6f);
            f32x4* o = (f32x4*)(out + (size_t)(m + rr) * D) + 2 * lane;
#pragma unroll
            for (int hf = 0; hf < 2; ++hf) { const f32x4 g0 = gr[128 * hf], g1 = gr[128 * hf + 1];
                __builtin_nontemporal_store((f32x4){x[8 * hf] * rs * g0[0], x[8 * hf + 1] * rs * g0[1], x[8 * hf + 2] * rs * g0[2], x[8 * hf + 3] * rs * g0[3]}, o + 128 * hf);
                __builtin_nontemporal_store((f32x4){x[8 * hf + 4] * rs * g1[0], x[8 * hf + 5] * rs * g1[1], x[8 * hf + 6] * rs * g1[2], x[8 * hf + 7] * rs * g1[3]}, o + 128 * hf + 1); } }
    }
}

constexpr int RTAB_OFF = 131072;
__device__ __forceinline__ void rstd_tables(const float* SSQ, const pg8::StaticOrder& S, LAS unsigned char* lds, int tid) {
    LAS float* tab = (LAS float*)(lds + RTAB_OFF); pg8::Unit u;
    const int r = tid & 255, sel = tid >> 8;
    for (int i0 = 0; i0 < 6; i0 += 2) {
        if (S.next(i0 + sel, u)) { const f32x4* p = (const f32x4*)(SSQ + (size_t)(u.pm * 256 + r) * 32); float s = 0.f;
#pragma unroll
            for (int k = 0; k < 8; ++k) { const f32x4 v = p[k]; s += (v[0] + v[1]) + (v[2] + v[3]); }
            tab[(i0 + sel) * 256 + r] = __builtin_amdgcn_rsqf(s * (1.0f / 1024.0f) + 1e-6f); }
    }
    __syncthreads();
}
__global__ void __launch_bounds__(NWAVES * 64, 2) fwd_megakernel(Args a) {
    extern __shared__ __attribute__((aligned(16))) unsigned char lds_raw[];
    cg::grid_group grid = cg::this_grid();
    LAS unsigned char* lds = (LAS unsigned char*)lds_raw;
    const int G = (int)gridDim.x, bx = (int)blockIdx.x;
    const int wave_s = __builtin_amdgcn_readfirstlane((int)threadIdx.x >> 6);
    { volatile LAS unsigned* misc = (volatile LAS unsigned*)(lds + MISC_OFF); if (threadIdx.x < 32) misc[threadIdx.x] = 0u; }
    __syncthreads();
    if (bx == 0) { unsigned* bw = (unsigned*)(KA(ws) + WS_BAR); for (int i = threadIdx.x; i < XCD_BAR_WORDS; i += NWAVES * 64) __hip_atomic_store(bw + i, 0u, __ATOMIC_RELAXED, __HIP_MEMORY_SCOPE_AGENT); }
#ifdef PROBE_TS
    int nst = 1; unsigned long long* tsb = (unsigned long long*)(KA(ws) + MiB);
    if (bx == 0 && threadIdx.x == 0) tsb[0] = __builtin_amdgcn_s_memrealtime();
#define GSYNC() do { xcd_barrier(xbar, wave_s == 0 && fresh_lane() == 0); if (bx == 0 && threadIdx.x == 0) tsb[nst] = __builtin_amdgcn_s_memrealtime(); ++nst; } while (0)
#define GSYNC0() do { grid.sync(); if (bx == 0 && threadIdx.x == 0) tsb[nst] = __builtin_amdgcn_s_memrealtime(); ++nst; } while (0)
#else
#define GSYNC() xcd_barrier(xbar, wave_s == 0 && fresh_lane() == 0)
#define GSYNC0() grid.sync()
#endif
#define TLW int lane_ = fresh_lane(); asm volatile("" : "+v"(lane_)); const int lane = lane_, wave = wave_s, tid = wave_s * 64 + lane_; (void)tid; (void)lane; (void)wave;
#define PHASE_VARS \
    unsigned char* ws = KA(ws); unsigned char* sc = ws + WS_SCR; bf16* XN = (bf16*)(ws + WS_XN); float* SSQ = (float*)(ws + WS_SSQ); float* X = KA(out); (void)sc; (void)XN; (void)SSQ; (void)X;


#ifndef NO_PRO
    { TLW prologue(lds, tid, lane, wave); }
#endif

    GSYNC0();
    XcdBarrier xbar = xcd_barrier_post((unsigned*)(KA(ws) + WS_BAR), (volatile LAS unsigned*)(lds + MISC_OFF) + 8);

    for (int layer = 0; layer < 4; ++layer) {
        const int kind = layer % 3;
        PHASE_VARS
        if (kind == 0) {
            const int li = layer / 3; const unsigned char* pb = ws + WS_S5P + (size_t)li * MiB;
            bf16* Z = (bf16*)(sc + SC_Z); f32x2* SLOC = (f32x2*)(sc + SC_SLOC); f32x2* CAR = (f32x2*)(sc + SC_CAR);

#ifndef NO_S5A
            { TLW s5_phaseA(pb, XN, SSQ, SLOC, lds, tid, lane, wave); }
#endif

            GSYNC();

#ifndef NO_S5B
            { TLW s5_phaseB(pb, SLOC, CAR, lds, tid); }
#endif

            GSYNC();

#ifndef NO_S5C
            { TLW s5_phaseC(pb, XN, SSQ, CAR, KA(s5_d) + li * D, KA(norm_mix) + layer * D, Z, lds, tid, lane, wave); }
#endif

            GSYNC();
            { pg8::Gemm g{Z, (const bf16*)(ws + WS_WGLU) + (size_t)li * 2048 * 1024, M, 2048, D}; pg8::StaticOrder S; S.init(M, 2048, G, bx);
              pg8::EpiGluResid E{(layer == 0) ? KA(x) : nullptr, XN, SSQ};

#ifndef NO_GGLU
              pg8::gemm_phase<pg8::EpiGluResid, pg8::StaticOrder, true, true>(lds, g, S, E, wave_s);
#endif
 }

            GSYNC();
        } else if (kind == 1) {
            bf16 *Qb = (bf16*)(sc + SC_GQ), *Kb = (bf16*)(sc + SC_GK), *Vb = (bf16*)(sc + SC_GV), *SGb = (bf16*)(sc + SC_GSG), *UPD = (bf16*)(sc + SC_GUPD), *O2 = (bf16*)(sc + SC_GO2);
            float *LA = (float*)(sc + SC_GLA), *DEC = (float*)(sc + SC_GDEC);
            { pg8::Gemm g{XN, (const bf16*)(ws + WS_WIN), M, 3584, D}; pg8::StaticOrder S; S.init(M, 3584, G, bx);
              { TLW rstd_tables(SSQ, S, lds, tid); }
              pg8::EpiGlaIn E{Qb, LA, KA(gla_b_a), (const LAS float*)(lds + RTAB_OFF)};

#ifndef NO_GIN
              pg8::gemm_phase<pg8::EpiGlaIn, pg8::StaticOrder, true, true>(lds, g, S, E, wave_s);
#endif
 }

            GSYNC();

#ifndef NO_G1
            { TLW gla_g1(Kb, Vb, LA, UPD, DEC, lds, tid, lane, wave); }
#endif

            GSYNC();

#ifndef NO_G2
            { TLW gla_g2(UPD, DEC, lds, tid); }
#endif

            GSYNC();

#ifndef NO_G3
            { TLW gla_g3(Qb, UPD, SGb, KA(gla_norm), O2, lds, tid, lane, wave); }
#endif

            GSYNC();
        } else {
            bf16 *Qb = (bf16*)(sc + SC_DQ), *Kb = (bf16*)(sc + SC_DK), *Vb = (bf16*)(sc + SC_DV), *Ob = (bf16*)(sc + SC_DO), *OC = (bf16*)(sc + SC_DOC);
            { pg8::Gemm g{XN, (const bf16*)(ws + WS_WQKV), M, 3072, D}; pg8::StaticOrder S; S.init(M, 3072, G, bx);
              { TLW rstd_tables(SSQ, S, lds, tid); }
              pg8::EpiDiffQkv E{Qb, KA(pos), (const LAS float*)(lds + RTAB_OFF)};

#ifndef NO_GQKV
              pg8::gemm_phase<pg8::EpiDiffQkv, pg8::StaticOrder, true, true>(lds, g, S, E, wave_s);
#endif
 }

            GSYNC();
            { const attn_body::AttnTensors AT{(const attn_body::bf16*)Qb, (const attn_body::bf16*)Kb, (const attn_body::bf16*)Vb, (attn_body::bf16*)Ob};
              const attn_body::StaticOrder S(G, bx);

#ifndef NO_ATTN
              attn_body::attn_phase<attn_body::StaticOrder>((char*)lds_raw, AT, S, wave_s);
#endif
 }

            GSYNC();

#ifndef NO_COMB
            { TLW diff_combine(Ob, OC, lane, wave); }
#endif

            GSYNC();
        }
        for (int st = (kind == 0 ? 1 : 0); st < 3; ++st) {
            if (st == 1) {
                pg8::Gemm g{XN, (const bf16*)(ws + WS_WGU) + (size_t)layer * 5632 * 1024, M, 5632, D}; pg8::StaticOrder S; S.init(M, 5632, G, bx);
                { TLW rstd_tables(SSQ, S, lds, tid); }
                pg8::EpiSwiglu E{(bf16*)(sc + SC_H), (const LAS float*)(lds + RTAB_OFF)};

#ifndef NO_GUP
                pg8::gemm_phase<pg8::EpiSwiglu, pg8::StaticOrder, true, true>(lds, g, S, E, wave_s);
#endif
                { const int nfull = (64 * 22) % G;
                  if (layer < 3 && nfull > 0 && bx >= nfull) { TLW convert_set(layer + 1, (bx - nfull) * NWAVES + wave, (G - nfull) * NWAVES, bx - nfull, G - nfull, lds, tid, lane, wave); }
                  else if (layer < 3 && nfull == 0) { TLW convert_set(layer + 1, bx * NWAVES + wave, G * NWAVES, bx, G, lds, tid, lane, wave); } }

            } else {
                const bf16* A; const bf16* Bt; int K;
                if (st == 0) { A = (kind == 1) ? (const bf16*)(sc + SC_GO2) : (const bf16*)(sc + SC_DOC); Bt = (kind == 1) ? (const bf16*)(ws + WS_WOG) : (const bf16*)(ws + WS_WOD); K = D; }
                else { A = (const bf16*)(sc + SC_H); Bt = (const bf16*)(ws + WS_WD) + (size_t)layer * 1024 * 2816; K = FF; }
                pg8::Gemm g{A, Bt, M, D, K}; pg8::StaticOrder S; S.init(M, D, G, bx);
                pg8::EpiResid E{XN, SSQ};

#ifndef NO_GRES
                pg8::gemm_phase<pg8::EpiResid, pg8::StaticOrder, true, true>(lds, g, S, E, wave_s);
#endif

            }
            GSYNC();
        }
    }

#ifndef NO_FIN
    { TLW final_norm((const bf16*)(KA(ws) + WS_XN), KA(out), KA(norm_final), lane, wave); }
#endif
#ifdef PROBE_TS
    GSYNC();
#ifdef PROBE_SYNCS
    for (int i = 0; i < 10; ++i) GSYNC();
#endif
    { const float T1 = ((float)(tsb[PROBE_A1] - tsb[PROBE_A0]) * 0.01f - PROBE_OFF) * PROBE_SCALE;
      if (bx == 0 && threadIdx.x == 0) KA(out)[0] = T1; }
#endif

}

extern "C" void kernel_launch(void* const* d_in, const int* in_sizes, int n_in, void* d_out, int out_size, void* d_ws, size_t ws_size, hipStream_t stream) {
    static int grid = 0;
    if (grid == 0) {
        if (n_in != 28 || in_sizes[0] != M * D || out_size != M * D || ws_size < WS_END) { fprintf(stderr, "kernel_launch: unexpected shapes (n_in %d, in0 %d, out %d, ws %zu need %zu)\n", n_in, n_in > 0 ? in_sizes[0] : -1, out_size, ws_size, (size_t)WS_END); grid = -1; return; }
        int dev = 0, cus = 0, per_cu = 0;
        hipGetDevice(&dev); hipDeviceGetAttribute(&cus, hipDeviceAttributeMultiprocessorCount, dev);
        if (hipFuncSetAttribute((const void*)fwd_megakernel, hipFuncAttributeMaxDynamicSharedMemorySize, LDS_BYTES) != hipSuccess) { fprintf(stderr, "kernel_launch: hipFuncSetAttribute failed\n"); grid = -1; return; }
        hipOccupancyMaxActiveBlocksPerMultiprocessor(&per_cu, (const void*)fwd_megakernel, NWAVES * 64, LDS_BYTES);
        if (per_cu < 1) { fprintf(stderr, "kernel_launch: occupancy query says %d blocks per CU\n", per_cu); per_cu = 1; }
        (void)hipGetLastError();
        grid = cus * 1;
    }
    if (grid < 0) return;
    Args a{};
    a.x = (const float*)d_in[0]; a.pos = (const int*)d_in[1]; a.norm_mix = (const float*)d_in[2]; a.norm_ffn = (const float*)d_in[3]; a.norm_final = (const float*)d_in[4];
    a.s5_lam_re = (const float*)d_in[5]; a.s5_lam_im = (const float*)d_in[6]; a.s5_log_dt = (const float*)d_in[7]; a.s5_b_re = (const float*)d_in[8]; a.s5_b_im = (const float*)d_in[9];
    a.s5_c_re = (const float*)d_in[10]; a.s5_c_im = (const float*)d_in[11]; a.s5_d = (const float*)d_in[12]; a.s5_w_glu = (const float*)d_in[13];
    a.gla_w_in = (const float*)d_in[14]; a.gla_w_a2 = (const float*)d_in[15]; a.gla_b_a = (const float*)d_in[16]; a.gla_norm = (const float*)d_in[17]; a.gla_w_o = (const float*)d_in[18];
    a.diff_w_qkv = (const float*)d_in[19]; a.diff_lq1 = (const float*)d_in[20]; a.diff_lk1 = (const float*)d_in[21]; a.diff_lq2 = (const float*)d_in[22]; a.diff_lk2 = (const float*)d_in[23];
    a.diff_subln = (const float*)d_in[24]; a.diff_w_o = (const float*)d_in[25]; a.ffn_w_gu = (const float*)d_in[26]; a.ffn_w_d = (const float*)d_in[27];
    a.out = (float*)d_out; a.ws = (unsigned char*)d_ws;
    void* args[] = {&a};
    hipError_t e = hipLaunchCooperativeKernel((const void*)fwd_megakernel, dim3(grid), dim3(NWAVES * 64), args, LDS_BYTES, stream);
    if (e != hipSuccess) fprintf(stderr, "cooperative launch failed: %s (grid %d)\n", hipGetErrorString(e), grid);
}
```
